# Optimizing an MI355X kernel written in HIP

```python
import math
import numpy as np
import jax
import jax.numpy as jnp
from jax import lax

D_MODEL = 2048
BATCH = 8
SEQ = 4096
DEPTH = 1

HEAD_DIM = 128
N_SB_HEADS = 8
N_NSA_HEADS = 8
N_NSA_KV = 2
NSA_GROUP = N_NSA_HEADS // N_NSA_KV
SB_WIDTH = N_SB_HEADS * HEAD_DIM
NSA_WIDTH = N_NSA_HEADS * HEAD_DIM
KV_WIDTH = N_NSA_KV * HEAD_DIM
MIX_WIDTH = SB_WIDTH + NSA_WIDTH
N_GATES = 3 * N_NSA_HEADS
IN_SPLITS = (SB_WIDTH, SB_WIDTH, SB_WIDTH, NSA_WIDTH, KV_WIDTH, KV_WIDTH, KV_WIDTH, KV_WIDTH, KV_WIDTH, KV_WIDTH, N_GATES)
IN_COLS = sum(IN_SPLITS)
Q_BLOCK = 128
CMP_BLOCK = 32
CMP_STRIDE = 16
CMP_HIDDEN = 256
SEL_BLOCK = 64
N_SELECT = 16
SEL_Q_CHUNK = 32
WINDOW = 512
N_BUCKETS = 32
MAX_DISTANCE = 128
PEER_HEADS = 8
PEER_N_KEYS = 128
PEER_N_EXPERTS = PEER_N_KEYS * PEER_N_KEYS
PEER_D_KEY = 256
PEER_TOPK = 16
PEER_TOKEN_CHUNK = 128
EPS = 1e-6
NEG = -1e30
BIG = 1e30

kernel_name = 'hybrid_sb_nsa_peer_layer'


def rms_norm(x, g):
    xf = x.astype(jnp.float32)
    y = xf * lax.rsqrt(jnp.mean(xf * xf, axis=-1, keepdims=True) + EPS)
    return (y * g.astype(jnp.float32)).astype(x.dtype)


def masked_softmax(s, valid):
    p = jax.nn.softmax(jnp.where(valid, s, NEG), axis=-1)
    return jnp.where(valid, p, 0.0)


def t5_bucket(dist):
    max_exact = N_BUCKETS // 2
    d = jnp.maximum(dist, 0)
    log_ratio = jnp.log(jnp.maximum(d, 1).astype(jnp.float32) / max_exact) / math.log(MAX_DISTANCE / max_exact)
    large = jnp.minimum(max_exact + (log_ratio * (N_BUCKETS - max_exact)).astype(jnp.int32), N_BUCKETS - 1)
    return jnp.where(d < max_exact, d, large)


def rel_bias_grid(table, dist):
    b = jnp.take(table, t5_bucket(dist), axis=0)
    return jnp.moveaxis(b, -1, 0).reshape(N_NSA_KV, NSA_GROUP, *dist.shape)


def stick_breaking_attention(q, k, v):
    B, H, T, Dh = q.shape
    scale = Dh ** -0.5
    kpos = jnp.arange(T)

    def block(i):
        qb = lax.dynamic_slice_in_dim(q, i * Q_BLOCK, Q_BLOCK, axis=2)
        qpos = i * Q_BLOCK + jnp.arange(Q_BLOCK)
        z = jnp.einsum('bhqd,bhkd->bhqk', qb, k, preferred_element_type=jnp.float32) * scale
        before = kpos[None, :] < qpos[:, None]
        log_keep = jnp.where(before, -jax.nn.softplus(z), 0.0)
        log_between = lax.cumsum(log_keep, axis=3, reverse=True) - log_keep
        a = jnp.where(before, jnp.exp(jax.nn.log_sigmoid(z) + log_between), 0.0)
        return jnp.einsum('bhqk,bhkd->bqhd', a.astype(v.dtype), v)

    out = lax.map(block, jnp.arange(T // Q_BLOCK))
    return jnp.moveaxis(out, 0, 1).reshape(B, T, H * Dh)


def compress_blocks(kv, pe, w1, w2):
    B, T, G, Dh = kv.shape
    nc = (T - CMP_BLOCK) // CMP_STRIDE + 1
    idx = jnp.arange(nc)[:, None] * CMP_STRIDE + jnp.arange(CMP_BLOCK)[None, :]
    blocks = kv[:, idx] + pe[None, None, :, None, :]
    flat = jnp.moveaxis(blocks, 3, 2).reshape(B, nc, G, CMP_BLOCK * Dh)
    return jax.nn.gelu(flat @ w1) @ w2


def block_overlap(nc, nb):
    c0 = np.arange(nc)[:, None] * CMP_STRIDE
    s0 = np.arange(nb)[None, :] * SEL_BLOCK
    ov = np.minimum(c0 + CMP_BLOCK, s0 + SEL_BLOCK) - np.maximum(c0, s0)
    return jnp.asarray(np.clip(ov, 0, None).astype(np.float32) / np.float32(CMP_BLOCK))


def compressed_attention(q, kc, vc, table):
    B, G, R, T, Dh = q.shape
    nc = kc.shape[2]
    nb = T // SEL_BLOCK
    scale = Dh ** -0.5
    c_end = jnp.arange(nc) * CMP_STRIDE + CMP_BLOCK - 1
    overlap = block_overlap(nc, nb)

    def block(i):
        qb = lax.dynamic_slice_in_dim(q, i * Q_BLOCK, Q_BLOCK, axis=3)
        qpos = i * Q_BLOCK + jnp.arange(Q_BLOCK)
        dist = qpos[:, None] - c_end[None, :]
        s = jnp.einsum('bgrqd,bgcd->bgrqc', qb, kc, preferred_element_type=jnp.float32) * scale + rel_bias_grid(table, dist)
        p = masked_softmax(s, dist >= 0)
        o = jnp.einsum('bgrqc,bgcd->bgrqd', p.astype(vc.dtype), vc)
        imp = jnp.einsum('bgrqc,cn->bgqn', p, overlap)
        return o, imp

    o, imp = lax.map(block, jnp.arange(T // Q_BLOCK))
    return (jnp.moveaxis(o, 0, 3).reshape(B, G, R, T, Dh), jnp.moveaxis(imp, 0, 2).reshape(B, G, T, nb))


def selected_attention(q, k, v, imp, table):
    B, G, R, T, Dh = q.shape
    nb = T // SEL_BLOCK
    n_sel = min(N_SELECT, nb)
    scale = Dh ** -0.5
    blk = jnp.arange(nb)
    cur = jnp.arange(T) // SEL_BLOCK
    forced = (blk[None, :] == 0) | (blk[None, :] == cur[:, None]) | (blk[None, :] == cur[:, None] - 1)
    future = blk[None, :] > cur[:, None]
    score = jnp.where(forced, BIG, jnp.where(future, NEG, imp))
    _, sel = lax.top_k(score, n_sel)
    kb = k.reshape(B, G, nb, SEL_BLOCK, Dh)
    vb = v.reshape(B, G, nb, SEL_BLOCK, Dh)
    gather = jax.vmap(jax.vmap(lambda blocks, ix: blocks[ix]))
    tab_gr = jnp.swapaxes(table.reshape(N_BUCKETS, G, R), 0, 1)
    g_index = jnp.arange(G)[None, :, None, None]
    n_keys = n_sel * SEL_BLOCK

    def chunk(i):
        qc = lax.dynamic_slice_in_dim(q, i * SEL_Q_CHUNK, SEL_Q_CHUNK, axis=3)
        ic = lax.dynamic_slice_in_dim(sel, i * SEL_Q_CHUNK, SEL_Q_CHUNK, axis=2)
        qpos = i * SEL_Q_CHUNK + jnp.arange(SEL_Q_CHUNK)
        kg = gather(kb, ic).reshape(B, G, SEL_Q_CHUNK, n_keys, Dh)
        vg = gather(vb, ic).reshape(B, G, SEL_Q_CHUNK, n_keys, Dh)
        kpos = (ic[..., None] * SEL_BLOCK + jnp.arange(SEL_BLOCK)).reshape(B, G, SEL_Q_CHUNK, n_keys)
        dist = qpos[None, None, :, None] - kpos
        bias = jnp.moveaxis(tab_gr[g_index, t5_bucket(dist)], -1, 2)
        s = jnp.einsum('bgrqd,bgqkd->bgrqk', qc, kg, preferred_element_type=jnp.float32) * scale + bias
        p = masked_softmax(s, (dist >= 0)[:, :, None])
        return jnp.einsum('bgrqk,bgqkd->bgrqd', p.astype(vg.dtype), vg)

    o = lax.map(chunk, jnp.arange(T // SEL_Q_CHUNK))
    return jnp.moveaxis(o, 0, 3).reshape(B, G, R, T, Dh)


def window_attention(q, k, v, table):
    B, G, R, T, Dh = q.shape
    scale = Dh ** -0.5
    span = WINDOW + Q_BLOCK
    kp = jnp.pad(k, ((0, 0), (0, 0), (WINDOW, 0), (0, 0)))
    vp = jnp.pad(v, ((0, 0), (0, 0), (WINDOW, 0), (0, 0)))

    def block(i):
        qb = lax.dynamic_slice_in_dim(q, i * Q_BLOCK, Q_BLOCK, axis=3)
        kb = lax.dynamic_slice_in_dim(kp, i * Q_BLOCK, span, axis=2)
        vb = lax.dynamic_slice_in_dim(vp, i * Q_BLOCK, span, axis=2)
        qpos = i * Q_BLOCK + jnp.arange(Q_BLOCK)
        kpos = i * Q_BLOCK - WINDOW + jnp.arange(span)
        dist = qpos[:, None] - kpos[None, :]
        valid = (dist >= 0) & (dist < WINDOW) & (kpos[None, :] >= 0)
        s = jnp.einsum('bgrqd,bgkd->bgrqk', qb, kb, preferred_element_type=jnp.float32) * scale + rel_bias_grid(table, dist)
        p = masked_softmax(s, valid)
        return jnp.einsum('bgrqk,bgkd->bgrqd', p.astype(vb.dtype), vb)

    o = lax.map(block, jnp.arange(T // Q_BLOCK))
    return jnp.moveaxis(o, 0, 3).reshape(B, G, R, T, Dh)


def hybrid_mixer(h, w_in, cmp_pe, cmp_k_w1, cmp_k_w2, cmp_v_w1, cmp_v_w2, q_norm_g, k_norm_g,
                 rel_bias_table, sb_out_g, nsa_out_g, w_out):
    B, T, _ = h.shape
    G, R, Dh = N_NSA_KV, NSA_GROUP, HEAD_DIM
    cuts = [int(c) for c in np.cumsum(IN_SPLITS)[:-1]]
    q_sb, k_sb, v_sb, q_nsa, k_cmp, v_cmp, k_slc, v_slc, k_win, v_win, gate_logits = jnp.split(h @ w_in, cuts, axis=-1)

    sb_heads = lambda t: t.reshape(B, T, N_SB_HEADS, Dh).transpose(0, 2, 1, 3)
    o_sb = stick_breaking_attention(sb_heads(q_sb), sb_heads(k_sb), sb_heads(v_sb))

    kv_heads = lambda t: t.reshape(B, T, G, Dh)
    to_bgtd = lambda t: t.transpose(0, 2, 1, 3)
    q = rms_norm(q_nsa.reshape(B, T, G, R, Dh), q_norm_g).transpose(0, 2, 3, 1, 4)
    kc = to_bgtd(rms_norm(compress_blocks(kv_heads(k_cmp), cmp_pe, cmp_k_w1, cmp_k_w2), k_norm_g))
    vc = to_bgtd(compress_blocks(kv_heads(v_cmp), cmp_pe, cmp_v_w1, cmp_v_w2))
    o_cmp, importance = compressed_attention(q, kc, vc, rel_bias_table)
    o_slc = selected_attention(q, to_bgtd(rms_norm(kv_heads(k_slc), k_norm_g)), to_bgtd(kv_heads(v_slc)), importance, rel_bias_table)
    o_win = window_attention(q, to_bgtd(rms_norm(kv_heads(k_win), k_norm_g)), to_bgtd(kv_heads(v_win)), rel_bias_table)
    gates = jax.nn.sigmoid(gate_logits).reshape(B, T, G, R, 3).transpose(0, 2, 3, 1, 4)
    o_nsa = gates[..., 0:1] * o_cmp + gates[..., 1:2] * o_slc + gates[..., 2:3] * o_win
    o_nsa = o_nsa.transpose(0, 3, 1, 2, 4).reshape(B, T, NSA_WIDTH)

    mixed = jnp.concatenate([rms_norm(o_sb, sb_out_g), rms_norm(o_nsa, nsa_out_g)], axis=-1)
    return mixed @ w_out


def peer_ffn(h, w_query, sub_keys, expert_u, expert_v):
    B, T, D = h.shape
    n_tok = B * T
    C = PEER_TOKEN_CHUNK
    half = PEER_D_KEY // 2

    def chunk(xc):
        qc = (xc @ w_query).reshape(C, PEER_HEADS, 2, half)
        s = jnp.einsum('chpd,hpnd->chpn', qc, sub_keys, preferred_element_type=jnp.float32)
        top_s, top_i = lax.top_k(s, PEER_TOPK)
        cand_s = (top_s[:, :, 0, :, None] + top_s[:, :, 1, None, :]).reshape(C, PEER_HEADS, PEER_TOPK * PEER_TOPK)
        cand_i = (top_i[:, :, 0, :, None] * PEER_N_KEYS + top_i[:, :, 1, None, :]).reshape(C, PEER_HEADS, PEER_TOPK * PEER_TOPK)
        best_s, best_pos = lax.top_k(cand_s, PEER_TOPK)
        expert_idx = jnp.take_along_axis(cand_i, best_pos, axis=-1)
        g = jax.nn.softmax(best_s, axis=-1)
        u = expert_u[expert_idx]
        vv = expert_v[expert_idx]
        act = jax.nn.gelu(jnp.einsum('chkd,cd->chk', u, xc, preferred_element_type=jnp.float32))
        return jnp.einsum('chk,chkd->cd', (g * act).astype(vv.dtype), vv)

    out = lax.map(chunk, h.reshape(n_tok // C, C, D))
    return out.reshape(B, T, D)


def setup_inputs(seed: int = 0) -> dict:
    key = jax.random.key(seed)
    ks = jax.random.split(key, 19)
    f32 = jnp.float32
    L = DEPTH

    def nrm(k, shape, scale):
        return jax.random.normal(k, shape, f32) * scale

    def gain(k, shape):
        return 1.0 + 0.02 * jax.random.normal(k, shape, f32)

    return {
        'x': nrm(ks[0], (BATCH, SEQ, D_MODEL), 1.0),
        'norm1_g': gain(ks[1], (L, D_MODEL)),
        'w_in': nrm(ks[2], (L, D_MODEL, IN_COLS), D_MODEL ** -0.5),
        'cmp_pe': nrm(ks[3], (L, CMP_BLOCK, HEAD_DIM), 0.2),
        'cmp_k_w1': nrm(ks[4], (L, CMP_BLOCK * HEAD_DIM, CMP_HIDDEN), (CMP_BLOCK * HEAD_DIM) ** -0.5),
        'cmp_k_w2': nrm(ks[5], (L, CMP_HIDDEN, HEAD_DIM), CMP_HIDDEN ** -0.5),
        'cmp_v_w1': nrm(ks[6], (L, CMP_BLOCK * HEAD_DIM, CMP_HIDDEN), (CMP_BLOCK * HEAD_DIM) ** -0.5),
        'cmp_v_w2': nrm(ks[7], (L, CMP_HIDDEN, HEAD_DIM), CMP_HIDDEN ** -0.5),
        'q_norm_g': gain(ks[8], (L, HEAD_DIM)),
        'k_norm_g': gain(ks[9], (L, HEAD_DIM)),
        'rel_bias_table': nrm(ks[10], (N_BUCKETS, N_NSA_HEADS), 0.5),
        'sb_out_g': gain(ks[11], (L, SB_WIDTH)),
        'nsa_out_g': gain(ks[12], (L, NSA_WIDTH)),
        'w_out': nrm(ks[13], (L, MIX_WIDTH, D_MODEL), MIX_WIDTH ** -0.5),
        'norm2_g': gain(ks[14], (L, D_MODEL)),
        'peer_w_query': nrm(ks[15], (L, D_MODEL, PEER_HEADS * PEER_D_KEY), D_MODEL ** -0.5),
        'peer_sub_keys': nrm(ks[16], (L, PEER_HEADS, 2, PEER_N_KEYS, PEER_D_KEY // 2), (PEER_D_KEY // 2) ** -0.5),
        'peer_expert_u': nrm(ks[17], (L, PEER_N_EXPERTS, D_MODEL), D_MODEL ** -0.5),
        'peer_expert_v': nrm(ks[18], (L, PEER_N_EXPERTS, D_MODEL), 0.5),
    }


def reference(x, norm1_g, w_in, cmp_pe, cmp_k_w1, cmp_k_w2, cmp_v_w1, cmp_v_w2, q_norm_g, k_norm_g,
              rel_bias_table, sb_out_g, nsa_out_g, w_out, norm2_g, peer_w_query, peer_sub_keys,
              peer_expert_u, peer_expert_v):
    for l in range(DEPTH):
        h = rms_norm(x, norm1_g[l])
        x = x + hybrid_mixer(h, w_in[l], cmp_pe[l], cmp_k_w1[l], cmp_k_w2[l], cmp_v_w1[l], cmp_v_w2[l],
                             q_norm_g[l], k_norm_g[l], rel_bias_table, sb_out_g[l], nsa_out_g[l], w_out[l])
        h = rms_norm(x, norm2_g[l])
        x = x + peer_ffn(h, peer_w_query[l], peer_sub_keys[l], peer_expert_u[l], peer_expert_v[l])
    return x
```

```cpp
#include <hip/hip_runtime.h>
#include <cstdio>
#include <cstdint>

#ifndef N_LAUNCH_MODE
#define N_LAUNCH_MODE 1
#endif

#define LAS __attribute__((address_space(3)))
typedef unsigned short bf16_t;
typedef short bf16x8 __attribute__((ext_vector_type(8)));
typedef float f32x4 __attribute__((ext_vector_type(4)));
typedef float f32x2 __attribute__((ext_vector_type(2)));
typedef unsigned u32x4 __attribute__((ext_vector_type(4)));
typedef unsigned u32x2 __attribute__((ext_vector_type(2)));

constexpr int NB = 8, NT = 4096, DM = 2048, NTOK = NB * NT;
constexpr int INC = 5656, INP = 5888;
constexpr float EPS = 1e-6f;
constexpr float LOG2E = 1.4426950408889634f;
constexpr float QSCALE = 0.08838834764831845f * 1.4426950408889634f;
constexpr int NPH = 12;

constexpr size_t WS_CTL = 0, CTL_BYTES = 65536;
constexpr size_t WS_WIN = WS_CTL + CTL_BYTES;
constexpr size_t WS_WOUT = WS_WIN + (size_t)INP * DM * 2;
constexpr size_t WS_WQ = WS_WOUT + (size_t)DM * DM * 2;
constexpr size_t WS_CW1 = WS_WQ + (size_t)DM * DM * 2;
constexpr size_t WS_CW2 = WS_CW1 + (size_t)2 * 256 * 4096 * 2;
constexpr size_t WS_CB = WS_CW2 + (size_t)2 * 128 * 256 * 2;
constexpr size_t WS_SUBK = WS_CB + 2 * 256 * 4;
constexpr size_t WS_EU = WS_SUBK + (size_t)8 * 2 * 128 * 128 * 2;
constexpr size_t WS_EV = WS_EU + (size_t)16384 * DM * 2;
constexpr size_t WS_A = WS_EV + (size_t)16384 * DM * 2;
constexpr size_t WS_ORAW = WS_A + (size_t)NTOK * DM * 2;
constexpr size_t WS_KC = WS_ORAW + (size_t)NTOK * DM * 2;
constexpr size_t WS_VCT = WS_KC + (size_t)16 * 256 * 128 * 2;
constexpr size_t SZ_BIG = (size_t)NTOK * 1024 * 2, SZ_SM = (size_t)NTOK * 256 * 2;
constexpr size_t WS_QSB = WS_VCT + (size_t)16 * 128 * 256 * 2;
constexpr size_t WS_KSB = WS_QSB + SZ_BIG;
constexpr size_t WS_VSBT = WS_KSB + SZ_BIG;
constexpr size_t WS_QN = WS_VSBT + SZ_BIG;
constexpr size_t WS_KCI = WS_QN + SZ_BIG;
constexpr size_t WS_VCI = WS_KCI + SZ_SM;
constexpr size_t WS_KSL = WS_VCI + SZ_SM;
constexpr size_t WS_VSLT = WS_KSL + SZ_SM;
constexpr size_t WS_KWI = WS_VSLT + SZ_SM;
constexpr size_t WS_VWIT = WS_KWI + SZ_SM;
constexpr size_t WS_GT = WS_VWIT + SZ_SM;
constexpr size_t WS_QN2 = WS_GT + (size_t)NTOK * 32 * 2;
constexpr size_t WS_KSL2 = WS_QN2 + SZ_BIG;
constexpr size_t WS_KWI2 = WS_KSL2 + SZ_SM;
constexpr size_t WS_H4 = WS_KWI2 + SZ_SM;
constexpr size_t WS_C4 = WS_H4 + (size_t)4 * NTOK * (DM / 2);
constexpr size_t WS_END = WS_C4 + (size_t)4 * NTOK * 64;
constexpr size_t WS_QP = WS_QSB;
constexpr size_t WS_PEI = WS_ORAW;
constexpr size_t WS_PWG = WS_ORAW + (size_t)NTOK * 128 * 4;
constexpr size_t WS_PW = WS_ORAW + (size_t)2 * NTOK * 128 * 4;
constexpr size_t WS_SLAB = WS_VSBT;
static_assert(WS_SLAB + (size_t)16 * NTOK * 128 * 4 <= WS_END, "slab must fit in the dead QKV region");

constexpr int LDS_BYTES = 147456;
constexpr int MISC_OFF = 131072;

struct Args { const float* in[19]; float* out; unsigned char* ws; int ph_lo, ph_hi, use_bar, pad; };

typedef __bf16 bf16x2v __attribute__((ext_vector_type(2)));
__device__ __forceinline__ unsigned cvt_pk_bf16(float lo, float hi) {
    const f32x2 v = {lo, hi}; union { bf16x2v b; unsigned u; } c; c.b = __builtin_convertvector(v, bf16x2v); return c.u;
}
__device__ __forceinline__ float bf_lo(unsigned u) { return __uint_as_float(u << 16); }
__device__ __forceinline__ float bf_hi(unsigned u) { return __uint_as_float(u & 0xffff0000u); }
__device__ __forceinline__ float fexp2(float x) { return __builtin_amdgcn_exp2f(x); }
__device__ __forceinline__ float frcp(float x) { return __builtin_amdgcn_rcpf(x); }
__device__ __forceinline__ float wave_sum(float v) {
#pragma unroll
    for (int o = 32; o > 0; o >>= 1) v += __shfl_xor(v, o);
    return v;
}
__device__ __forceinline__ float gelu_tanh(float x) {
    const float y = 0.7978845608028654f * (x + 0.044715f * x * x * x);
    const float e = fexp2(2.0f * LOG2E * y);
    return x * (1.0f - frcp(1.0f + e));
}

__device__ __forceinline__ unsigned row4_max_u32(unsigned m) {
    const u32x2 s = __builtin_amdgcn_permlane32_swap(m, m, false, false);
    const unsigned t = s.x > s.y ? s.x : s.y;
    const u32x2 u = __builtin_amdgcn_permlane16_swap(t, t, false, false);
    return u.x > u.y ? u.x : u.y;
}
__device__ __forceinline__ float row4_max_f32(float m) {
    const u32x2 s = __builtin_amdgcn_permlane32_swap(__float_as_uint(m), __float_as_uint(m), false, false);
    const float t = fmaxf(__uint_as_float(s.x), __uint_as_float(s.y));
    const u32x2 u = __builtin_amdgcn_permlane16_swap(__float_as_uint(t), __float_as_uint(t), false, false);
    return fmaxf(__uint_as_float(u.x), __uint_as_float(u.y));
}
__device__ __forceinline__ float row4_sum_f32(float m) {
    const u32x2 s = __builtin_amdgcn_permlane32_swap(__float_as_uint(m), __float_as_uint(m), false, false);
    const float t = __uint_as_float(s.x) + __uint_as_float(s.y);
    const u32x2 u = __builtin_amdgcn_permlane16_swap(__float_as_uint(t), __float_as_uint(t), false, false);
    return __uint_as_float(u.x) + __uint_as_float(u.y);
}
__device__ __forceinline__ unsigned f2sort(float v) { const unsigned b = __float_as_uint(v); return b ^ ((unsigned)((int)b >> 31) | 0x80000000u); }
__device__ __forceinline__ float sort2f(unsigned u) { return __uint_as_float((u >> 31) ? (u ^ 0x80000000u) : ~u); }

template <int N, int M>
__device__ __forceinline__ void bitonic_sort_desc(unsigned (&v)[M], int base) {
#pragma unroll
    for (int k = 2; k <= N; k <<= 1)
#pragma unroll
        for (int j = k >> 1; j > 0; j >>= 1)
#pragma unroll
            for (int i = 0; i < N; ++i) {
                const int l = i ^ j;
                if (l > i) {
                    const unsigned a = v[base + i], b = v[base + l];
                    const unsigned hi = a > b ? a : b, lo = a > b ? b : a;
                    const bool desc = (i & k) == 0;
                    v[base + i] = desc ? hi : lo; v[base + l] = desc ? lo : hi;
                }
            }
}
template <int N>
__device__ __forceinline__ void bitonic_merge_desc(unsigned (&v)[N]) {
#pragma unroll
    for (int j = N >> 1; j > 0; j >>= 1)
#pragma unroll
        for (int i = 0; i < N; ++i) {
            const int l = i ^ j;
            if (l > i) { const unsigned a = v[i], b = v[l]; v[i] = a > b ? a : b; v[l] = a > b ? b : a; }
        }
}
__device__ __forceinline__ unsigned partner32(unsigned x, int lane) { const u32x2 s = __builtin_amdgcn_permlane32_swap(x, x, false, false); return (lane & 32) ? s.x : s.y; }
__device__ __forceinline__ unsigned partner16(unsigned x, int lane) { const u32x2 s = __builtin_amdgcn_permlane16_swap(x, x, false, false); return (lane & 16) ? s.x : s.y; }
__device__ __forceinline__ bf16x8 as_bf16x8(u32x4 v) { union { u32x4 u; bf16x8 b; } c; c.u = v; return c.b; }
#define MFMA16(a, b, c) __builtin_amdgcn_mfma_f32_16x16x32_bf16((a), (b), (c), 0, 0, 0)

#define XB_TMO      128
#define XB_XCNT(j)  (256  + 64 * (j))
#define XB_XSUB(j)  (1280 + 64 * (j))
#define XB_XGEN(j)  (2304 + 64 * (j))
#define XB_TOP      3328
#define XB_TOPGEN   3392
#define XCD_BAR_WORDS 3456
#define XB_SPIN_CAP (1u << 20)
__device__ __forceinline__ unsigned xb_ld(unsigned* p)              { return __hip_atomic_load(p, __ATOMIC_RELAXED, __HIP_MEMORY_SCOPE_AGENT); }
__device__ __forceinline__ unsigned xb_add(unsigned* p, unsigned v) { return __hip_atomic_fetch_add(p, v, __ATOMIC_RELAXED, __HIP_MEMORY_SCOPE_AGENT); }
__device__ __forceinline__ unsigned xb_xcc_id() { return (unsigned)__builtin_amdgcn_s_getreg((3 << 11) | 20) & 0xFu; }
#define XB_SPIN(cond, bar) do { unsigned _sp = 0; while (cond) { __builtin_amdgcn_s_sleep(1); \
    if ((++_sp & 255u) == 0u) { if (xb_ld(&(bar)[XB_TMO])) break; if (_sp > XB_SPIN_CAP) { atomicAdd(&(bar)[XB_TMO], 1u); break; } } } } while (0)
struct XcdBarrier { unsigned* bar; unsigned x; volatile LAS unsigned* st; };
__device__ __forceinline__ XcdBarrier xcd_barrier_post(unsigned* bar, volatile LAS unsigned* st) {
    XcdBarrier b; b.bar = bar; b.x = xb_xcc_id(); b.st = st;
    if (threadIdx.x == 0) (void)xb_add(&bar[XB_XCNT(b.x)], 1u);
    return b;
}
__device__ __forceinline__ void xcd_barrier_complete(unsigned* bar, unsigned x, unsigned& nloc, unsigned& nx) {
    const unsigned G = gridDim.x * gridDim.y * gridDim.z;
    unsigned sum, cnt, mine, sp = 0u;
    for (;;) {
        sum = 0u; cnt = 0u; mine = 0u;
#pragma unroll
        for (unsigned j = 0; j < 16; ++j) { const unsigned c = xb_ld(&bar[XB_XCNT(j)]); sum += c; cnt += (c > 0u) ? 1u : 0u; mine = (j == x) ? c : mine; }
        if (sum == G) break;
        __builtin_amdgcn_s_sleep(1);
        if ((++sp & 255u) == 0u) { if (xb_ld(&bar[XB_TMO])) break; if (sp > XB_SPIN_CAP) { atomicAdd(&bar[XB_TMO], 1u); break; } }
    }
    nloc = mine > 0u ? mine : 1u; nx = cnt > 0u ? cnt : 1u;
}
__device__ __forceinline__ void xcd_barrier(const XcdBarrier& b) {
    asm volatile("s_waitcnt vmcnt(0)" ::: "memory");
    __syncthreads();
    if (threadIdx.x == 0) {
        unsigned* bar = b.bar;
        __builtin_amdgcn_s_waitcnt(0);
        unsigned nloc = b.st[0], nx = b.st[1];
        if (nloc == 0u) { xcd_barrier_complete(bar, b.x, nloc, nx); b.st[0] = nloc; b.st[1] = nx; }
        const unsigned old = xb_add(&bar[XB_XSUB(b.x)], 1u);
        const unsigned gen = old / nloc;
        if (old + 1u == (gen + 1u) * nloc) {
            __builtin_amdgcn_fence(__ATOMIC_RELEASE, "agent");
            asm volatile("s_waitcnt vmcnt(0)" ::: "memory");
            const unsigned og = xb_add(&bar[XB_TOP], 1u);
            const unsigned tg = og / nx;
            if (og + 1u == (tg + 1u) * nx) xb_add(&bar[XB_TOPGEN], 1u);
            else XB_SPIN(xb_ld(&bar[XB_TOPGEN]) == tg, bar);
            __builtin_amdgcn_fence(__ATOMIC_ACQUIRE, "agent");
            xb_add(&bar[XB_XGEN(b.x)], 1u);
            asm volatile("s_waitcnt vmcnt(0)" ::: "memory");
        } else {
            XB_SPIN(xb_ld(&bar[XB_XGEN(b.x)]) == gen, bar);
            __builtin_amdgcn_fence(__ATOMIC_ACQUIRE, "agent");
            asm volatile("s_waitcnt vmcnt(0)" ::: "memory");
        }
    }
    __syncthreads();
}

namespace pg8 {
constexpr int BM = 256, BK = 64, HALF = 128, HTB = HALF * BK * 2, STAGE_BYTES = 8 * HTB, NXCD = 8, WGM = 8;
__device__ __forceinline__ int lds_byte(int r, int c) { const int st = (r >> 4) * 2 + (c >> 5), rr = r & 15, cc = c & 31, ob = rr * 64 + cc * 2; return st * 1024 + (ob ^ (((ob >> 9) & 1) << 5)); }
__device__ __forceinline__ void stage_rc(int b, int& R, int& C) { const int st = b / 1024, sb = b % 1024, swz = sb ^ (((sb >> 9) & 1) << 5); R = (st >> 1) * 16 + swz / 64; C = (st & 1) * 32 + (swz % 64) / 2; }
__device__ __forceinline__ int perm32(int rho) { const int n = rho >> 4, i = rho & 15; return 8 * (i >> 2) + 4 * n + (i & 3); }
struct Unit { int pm, pn; };
struct Gemm { const bf16_t* A; const bf16_t* Bt; int M, N, K; };
struct StaticOrder {
    int nM, nN, nwg, G, c;
    __device__ void init(int M, int N, int G_, int c_) { nM = M / BM; nN = N / BM; nwg = nM * nN; G = G_; c = c_; }
    __device__ bool next(int i, Unit& u) const {
        const long L = (long)i * G + c; if (L >= nwg) return false;
        int wgid = (int)L; { const int q = nwg / NXCD, r = nwg % NXCD, xcd = wgid % NXCD, off = wgid / NXCD; wgid = (xcd < r ? xcd * (q + 1) : r * (q + 1) + (xcd - r) * q) + off; }
        const int nig = WGM * nN, gid = wgid / nig, fm = gid * WGM, gsz = (nM - fm) < WGM ? (nM - fm) : WGM;
        u.pm = fm + ((wgid % nig) % gsz); u.pn = (wgid % nig) / gsz; return true;
    }
    __device__ __forceinline__ void a_ready(const Unit&) const {}
    __device__ __forceinline__ void done(const Unit&) const {}
};

template <class Epi, class Sched>
__device__ __forceinline__ void gemm_phase(LAS unsigned char* lds, const Gemm g, const Sched& S, const Epi& E) {
    const int tid = threadIdx.x, wid = __builtin_amdgcn_readfirstlane(tid >> 6), lane = tid & 63, wr = wid >> 2, wc = wid & 3, fr = lane & 15, fq = lane >> 4;
    const int K = g.K, nt = K / BK;
    unsigned voffA[2], voffB[2];
#pragma unroll
    for (int i = 0; i < 2; ++i) { int R, C; stage_rc(tid * 16 + i * 8192, R, C); const int Rb = Epi::PERM ? ((R & ~31) + perm32(R & 31)) : R;
        voffA[i] = (unsigned)(R * K + C) * 2u; voffB[i] = (unsigned)(Rb * K + C) * 2u; }
    const size_t kstep = (size_t)(BK * 2);
    const size_t hstep = (size_t)HALF * K * 2;
    const size_t tstep = 2 * hstep;
    const unsigned ldsw = (unsigned)wid * 1024u;
    const int aoff = lds_byte(wr * 64 + fr, fq * 8), boff = lds_byte(wc * 32 + fr, fq * 8);
#define PG8_SA(b, h) (((b) * 2 + (h)) * HTB)
#define PG8_SB(b, h) ((4 + (b) * 2 + (h)) * HTB)
#define PG8_STAGE(bufoff, gbase, voff) do { _Pragma("unroll") for (int _i = 0; _i < 2; ++_i) \
        __builtin_amdgcn_global_load_lds((const unsigned*)((const char*)(gbase) + (voff)[_i]), (LAS unsigned*)(lds + (bufoff) + ldsw + _i * 8192), 16, 0, 0); } while (0)
#define PG8_LDA(dst, b, h) do { _Pragma("unroll") for (int m = 0; m < 4; ++m) _Pragma("unroll") for (int k = 0; k < 2; ++k) dst[m][k] = *(const LAS bf16x8*)(lds + PG8_SA(b, h) + aoff + m * 2048 + k * 1024); } while (0)
#define PG8_LDB(dst, b, h) do { _Pragma("unroll") for (int n = 0; n < 2; ++n) _Pragma("unroll") for (int k = 0; k < 2; ++k) dst[n][k] = *(const LAS bf16x8*)(lds + PG8_SB(b, h) + boff + n * 2048 + k * 1024); } while (0)
#define PG8_MMA(ai, bj, At, Bt) do { __builtin_amdgcn_s_setprio(1); _Pragma("unroll") for (int m = 0; m < 4; ++m) _Pragma("unroll") for (int n = 0; n < 2; ++n) _Pragma("unroll") for (int k = 0; k < 2; ++k) \
        acc[ai][bj][m][n] = __builtin_amdgcn_mfma_f32_16x16x32_bf16(Bt[n][k], At[m][k], acc[ai][bj][m][n], 0, 0, 0); __builtin_amdgcn_s_setprio(0); } while (0)
#define PG8_WAIT_V(n) asm volatile("s_waitcnt vmcnt(" #n ")" ::: "memory")
#define PG8_WAIT_L(n) asm volatile("s_waitcnt lgkmcnt(" #n ")" ::: "memory")
#define PG8_BAR __builtin_amdgcn_s_barrier()
#define PG8_SCHED __builtin_amdgcn_sched_barrier(0)
    Unit cur, nxt; int ui = 0;
    if (!S.next(0, cur)) return;
    f32x4 acc[2][2][4][2];
#pragma unroll
    for (int a = 0; a < 2; ++a)
#pragma unroll
        for (int b = 0; b < 2; ++b)
#pragma unroll
            for (int m = 0; m < 4; ++m)
#pragma unroll
                for (int n = 0; n < 2; ++n) acc[a][b][m][n] = (f32x4){0.f, 0.f, 0.f, 0.f};
    bf16x8 At[4][2], B0[2][2], B1[2][2];
    const char* cA = (const char*)g.A + (size_t)cur.pm * tstep; const char* cB = (const char*)g.Bt + (size_t)cur.pn * tstep;
    S.a_ready(cur);
    PG8_STAGE(PG8_SB(0, 0), cB, voffB); PG8_STAGE(PG8_SA(0, 0), cA, voffA); PG8_STAGE(PG8_SB(0, 1), cB + hstep, voffB); PG8_STAGE(PG8_SA(0, 1), cA + hstep, voffA);
    if (wr == 1) PG8_BAR;
    PG8_WAIT_V(4); PG8_BAR;
    PG8_STAGE(PG8_SB(1, 0), cB + kstep, voffB); PG8_STAGE(PG8_SA(1, 0), cA + kstep, voffA); PG8_STAGE(PG8_SB(1, 1), cB + hstep + kstep, voffB);
    PG8_WAIT_V(6); PG8_BAR;
    for (;;) {
        const bool has_next = S.next(ui + 1, nxt);
        const char* nA = has_next ? (const char*)g.A + (size_t)nxt.pm * tstep : cA; const char* nB = has_next ? (const char*)g.Bt + (size_t)nxt.pn * tstep : cB;
        for (int t = 0; t < nt; t += 2) {
            const bool last = (t == nt - 2);
            const char* a1 = cA + (size_t)(t + 1) * kstep;
            const char* a2 = last ? nA : cA + (size_t)(t + 2) * kstep; const char* b2 = last ? nB : cB + (size_t)(t + 2) * kstep;
            const char* a3 = a2 + kstep; const char* b3 = b2 + kstep;
            if (last && has_next) S.a_ready(nxt);
            PG8_LDB(B0, 0, 0); PG8_SCHED; PG8_LDA(At, 0, 0); PG8_STAGE(PG8_SA(1, 1), a1 + hstep, voffA);
            PG8_WAIT_L(8); PG8_BAR; PG8_WAIT_L(0); PG8_MMA(0, 0, At, B0); PG8_BAR; PG8_SCHED;
            PG8_LDB(B1, 0, 1); PG8_STAGE(PG8_SB(0, 0), b2, voffB);
            PG8_BAR; PG8_WAIT_L(0); PG8_MMA(0, 1, At, B1); PG8_BAR;
            PG8_LDA(At, 0, 1); PG8_STAGE(PG8_SA(0, 0), a2, voffA);
            PG8_BAR; PG8_WAIT_L(0); PG8_MMA(1, 0, At, B0); PG8_BAR; PG8_SCHED;
            PG8_STAGE(PG8_SB(0, 1), b2 + hstep, voffB);
            PG8_WAIT_V(6); PG8_BAR; PG8_MMA(1, 1, At, B1); PG8_BAR;
            PG8_LDB(B0, 1, 0); PG8_SCHED; PG8_LDA(At, 1, 0); PG8_STAGE(PG8_SA(0, 1), a2 + hstep, voffA);
            PG8_WAIT_L(8); PG8_BAR; PG8_WAIT_L(0); PG8_MMA(0, 0, At, B0); PG8_BAR; PG8_SCHED;
            PG8_LDB(B1, 1, 1); PG8_STAGE(PG8_SB(1, 0), b3, voffB);
            PG8_BAR; PG8_WAIT_L(0); PG8_MMA(0, 1, At, B1); PG8_BAR;
            PG8_LDA(At, 1, 1); PG8_STAGE(PG8_SA(1, 0), a3, voffA);
            PG8_BAR; PG8_WAIT_L(0); PG8_MMA(1, 0, At, B0); PG8_BAR; PG8_SCHED;
            PG8_STAGE(PG8_SB(1, 1), b3 + hstep, voffB);
            PG8_WAIT_V(6); PG8_BAR; PG8_MMA(1, 1, At, B1); PG8_BAR;
        }
        E(acc, cur, wr, wc, fr, fq); S.done(cur);
        if (!has_next) break;
#pragma unroll
        for (int a = 0; a < 2; ++a)
#pragma unroll
            for (int b = 0; b < 2; ++b)
#pragma unroll
                for (int m = 0; m < 4; ++m)
#pragma unroll
                    for (int n = 0; n < 2; ++n) acc[a][b][m][n] = (f32x4){0.f, 0.f, 0.f, 0.f};
        cur = nxt; cA = nA; cB = nB; ++ui;
    }
    PG8_WAIT_V(0);
    if (wr == 0) PG8_BAR;
    PG8_BAR;
#undef PG8_SA
#undef PG8_SB
#undef PG8_STAGE
#undef PG8_LDA
#undef PG8_LDB
#undef PG8_MMA
#undef PG8_WAIT_V
#undef PG8_WAIT_L
#undef PG8_BAR
#undef PG8_SCHED
}
}

struct EpiIn {
    static constexpr bool PERM = true;
    unsigned char* ws;
    __device__ __forceinline__ void operator()(const f32x4 (&acc)[2][2][4][2], const pg8::Unit& u, int wr, int wc, int fr, int fq) const {
#pragma unroll
        for (int bj = 0; bj < 2; ++bj) {
            const int gi = u.pn * 2 + bj;
            int mode; size_t off; int ld, hh = 0, nh = 1;
            if (gi < 8)       { mode = 0; off = WS_QSB + (size_t)gi * 256; ld = 1024; }
            else if (gi < 16) { mode = 4; off = WS_KSB; hh = gi - 8; nh = 8; ld = 0; }
            else if (gi < 24) { mode = 1; off = WS_VSBT; hh = gi - 16; nh = 8; ld = 0; }
            else if (gi < 32) { mode = 0; off = WS_QN + (size_t)(gi - 24) * 256; ld = 1024; }
            else if (gi < 34) { mode = 0; off = WS_KCI + (size_t)(gi - 32) * 256; ld = 256; }
            else if (gi < 36) { mode = 0; off = WS_VCI + (size_t)(gi - 34) * 256; ld = 256; }
            else if (gi < 38) { mode = 0; off = WS_KSL + (size_t)(gi - 36) * 256; ld = 256; }
            else if (gi < 40) { mode = 1; off = WS_VSLT; hh = gi - 38; nh = 2; ld = 0; }
            else if (gi < 42) { mode = 0; off = WS_KWI + (size_t)(gi - 40) * 256; ld = 256; }
            else if (gi < 44) { mode = 1; off = WS_VWIT; hh = gi - 42; nh = 2; ld = 0; }
            else if (gi == 44) { mode = 2; off = WS_GT; ld = 32; }
            else { mode = 3; off = 0; ld = 0; }
            if (mode == 3) continue;
            const int cin = wc * 32 + 8 * fq;
            bf16_t* base = (bf16_t*)(ws + off);
#pragma unroll
            for (int ai = 0; ai < 2; ++ai)
#pragma unroll
                for (int m = 0; m < 4; ++m) {
                    const int row = u.pm * 256 + ai * 128 + wr * 64 + m * 16 + fr;
                    const f32x4 v0 = acc[ai][bj][m][0], v1 = acc[ai][bj][m][1];
                    u32x4 w; w.x = cvt_pk_bf16(v0[0], v0[1]); w.y = cvt_pk_bf16(v0[2], v0[3]); w.z = cvt_pk_bf16(v1[0], v1[1]); w.w = cvt_pk_bf16(v1[2], v1[3]);
                    if (mode == 0) { *(u32x4*)(base + (size_t)row * ld + cin) = w; }
                    else if (mode == 4) { *(u32x4*)(base + ((size_t)((row >> 12) * nh + hh) * NT + (row & 4095)) * 128 + cin) = w; }
                    else if (mode == 2) { if (cin < 32) *(u32x4*)(base + (size_t)row * 32 + cin) = w; }
                    else {
                        const int b = row >> 12, t = row & 4095;
                        bf16_t* p = base + (((size_t)(b * nh + hh) * 64 + (t >> 6)) * 128 + cin) * 64 + (t & 63);
                        p[0 * 64] = (bf16_t)(w.x & 0xffffu); p[1 * 64] = (bf16_t)(w.x >> 16);
                        p[2 * 64] = (bf16_t)(w.y & 0xffffu); p[3 * 64] = (bf16_t)(w.y >> 16);
                        p[4 * 64] = (bf16_t)(w.z & 0xffffu); p[5 * 64] = (bf16_t)(w.z >> 16);
                        p[6 * 64] = (bf16_t)(w.w & 0xffffu); p[7 * 64] = (bf16_t)(w.w >> 16);
                    }
                }
        }
    }
};
struct EpiResF32 {
    static constexpr bool PERM = false;
    const float* res; float* out;
    __device__ __forceinline__ void operator()(const f32x4 (&acc)[2][2][4][2], const pg8::Unit& u, int wr, int wc, int fr, int fq) const {
        const int row0 = u.pm * 256 + wr * 64 + fr, col0 = u.pn * 256 + wc * 32 + 4 * fq;
#pragma unroll
        for (int ai = 0; ai < 2; ++ai)
#pragma unroll
            for (int m = 0; m < 4; ++m) {
                const size_t ro = (size_t)(row0 + ai * 128 + m * 16) * DM + col0;
#pragma unroll
                for (int bj = 0; bj < 2; ++bj)
#pragma unroll
                    for (int n = 0; n < 2; ++n) {
                        const f32x4 r = *(const f32x4*)(res + ro + bj * 128 + n * 16);
                        f32x4 vv = acc[ai][bj][m][n] + r;
                        *(f32x4*)(out + ro + bj * 128 + n * 16) = vv;
                    }
            }
    }
};
struct EpiBf16Row {
    static constexpr bool PERM = true;
    bf16_t* O; int ld;
    __device__ __forceinline__ void operator()(const f32x4 (&acc)[2][2][4][2], const pg8::Unit& u, int wr, int wc, int fr, int fq) const {
        const int row0 = u.pm * 256 + wr * 64 + fr, col0 = u.pn * 256 + wc * 32 + 8 * fq;
#pragma unroll
        for (int ai = 0; ai < 2; ++ai)
#pragma unroll
            for (int m = 0; m < 4; ++m) {
                bf16_t* rowp = O + (size_t)(row0 + ai * 128 + m * 16) * ld + col0;
#pragma unroll
                for (int bj = 0; bj < 2; ++bj) {
                    const f32x4 v0 = acc[ai][bj][m][0], v1 = acc[ai][bj][m][1];
                    u32x4 w; w.x = cvt_pk_bf16(v0[0], v0[1]); w.y = cvt_pk_bf16(v0[2], v0[3]); w.z = cvt_pk_bf16(v1[0], v1[1]); w.w = cvt_pk_bf16(v1[2], v1[3]);
                    *(u32x4*)(rowp + bj * 128) = w;
                }
            }
    }
};

__device__ __forceinline__ void transpose_cvt(const float* __restrict__ src, int K, int N, bf16_t* __restrict__ dst, int Npad, LAS float* tile) {
    const int tid = threadIdx.x, ntn = Npad / 64, ntk = K / 64;
    for (int ti = blockIdx.x; ti < ntn * ntk; ti += gridDim.x) {
        const int n0 = (ti % ntn) * 64, k0 = (ti / ntn) * 64;
#pragma unroll
        for (int i = 0; i < 2; ++i) {
            const int kk = (tid >> 4) + i * 32, nn = (tid & 15) * 4;
            f32x4 v = (f32x4){0.f, 0.f, 0.f, 0.f};
            if (n0 + nn < N) v = *(const f32x4*)(src + (size_t)(k0 + kk) * N + n0 + nn);
            tile[kk * 65 + nn + 0] = v[0]; tile[kk * 65 + nn + 1] = v[1]; tile[kk * 65 + nn + 2] = v[2]; tile[kk * 65 + nn + 3] = v[3];
        }
        __syncthreads();
        {
            const int nn = tid >> 3, k8 = (tid & 7) * 8;
            float f[8];
#pragma unroll
            for (int j = 0; j < 8; ++j) f[j] = tile[(k8 + j) * 65 + nn];
            u32x4 w; w.x = cvt_pk_bf16(f[0], f[1]); w.y = cvt_pk_bf16(f[2], f[3]); w.z = cvt_pk_bf16(f[4], f[5]); w.w = cvt_pk_bf16(f[6], f[7]);
            *(u32x4*)(dst + (size_t)(n0 + nn) * K + k0 + k8) = w;
        }
        __syncthreads();
    }
}
__device__ __forceinline__ void cvt_copy(const float* __restrict__ src, bf16_t* __restrict__ dst, size_t n) {
    const size_t stride = (size_t)gridDim.x * 512 * 8;
    for (size_t i = ((size_t)blockIdx.x * 512 + threadIdx.x) * 8; i < n; i += stride) {
        const f32x4 a = *(const f32x4*)(src + i), b = *(const f32x4*)(src + i + 4);
        u32x4 w; w.x = cvt_pk_bf16(a[0], a[1]); w.y = cvt_pk_bf16(a[2], a[3]); w.z = cvt_pk_bf16(b[0], b[1]); w.w = cvt_pk_bf16(b[2], b[3]);
        *(u32x4*)(dst + i) = w;
    }
}
__device__ __forceinline__ void cvt_fp4(const float* __restrict__ src, unsigned char* __restrict__ dst, size_t n, float scale) {
    const size_t stride = (size_t)gridDim.x * 512 * 32;
    for (size_t i = ((size_t)blockIdx.x * 512 + threadIdx.x) * 32; i < n; i += stride) {
        u32x4 w;
#pragma unroll
        for (int j = 0; j < 4; ++j) {
            const f32x4 a0 = *(const f32x4*)(src + i + j * 8), a1 = *(const f32x4*)(src + i + j * 8 + 4);
            unsigned p = 0u;
            p = __builtin_amdgcn_cvt_scalef32_pk_fp4_f32(p, a0[0] * scale, a0[1] * scale, 1.0f, 0); p = __builtin_amdgcn_cvt_scalef32_pk_fp4_f32(p, a0[2] * scale, a0[3] * scale, 1.0f, 1);
            p = __builtin_amdgcn_cvt_scalef32_pk_fp4_f32(p, a1[0] * scale, a1[1] * scale, 1.0f, 2); p = __builtin_amdgcn_cvt_scalef32_pk_fp4_f32(p, a1[2] * scale, a1[3] * scale, 1.0f, 3);
            w[j] = p;
        }
        const size_t e = i >> 11, d = i & 2047;
        *(u32x4*)(dst + (((d >> 8) * 16384 + e) << 7) + ((d & 255) >> 1)) = w;
    }
}
__device__ __forceinline__ void cvt_fp4_vperm(const float* __restrict__ src, unsigned char* __restrict__ dst, float scale) {
    const int lane = threadIdx.x & 63, c = lane >> 2, q = lane & 3;
    for (int it = blockIdx.x * 8 + (threadIdx.x >> 6); it < 16384 * 8; it += gridDim.x * 8) {
        const int e = it >> 3, sl = it & 7;
        const f32x4 v = *(const f32x4*)(src + (size_t)e * DM + sl * 256 + lane * 4);
        unsigned p = 0u;
        p = __builtin_amdgcn_cvt_scalef32_pk_fp4_f32(p, v[0] * scale, v[1] * scale, 1.0f, 0); p = __builtin_amdgcn_cvt_scalef32_pk_fp4_f32(p, v[2] * scale, v[3] * scale, 1.0f, 1);
        const unsigned pn = (unsigned)__shfl_down((int)p, 4);
        if ((c & 1) == 0) {
            unsigned char* o = dst + ((((size_t)sl * 16384 + e) << 7)) + q * 8 + (c >> 1);
#pragma unroll
            for (int k = 0; k < 4; ++k) o[k * 32] = (unsigned char)(((p >> (4 * k)) & 15u) | (((pn >> (4 * k)) & 15u) << 4));
        }
    }
}
__device__ __forceinline__ void rms_rows(const float* __restrict__ src, const float* __restrict__ gain, bf16_t* __restrict__ dst, unsigned char* __restrict__ hi8 = nullptr, unsigned char* __restrict__ lo8 = nullptr) {
    const int lane = threadIdx.x & 63, wave = threadIdx.x >> 6;
    f32x4 g[8];
#pragma unroll
    for (int i = 0; i < 8; ++i) g[i] = *(const f32x4*)(gain + i * 256 + lane * 4);
    for (int row = blockIdx.x * 8 + wave; row < NTOK; row += gridDim.x * 8) {
        const float* p = src + (size_t)row * DM + lane * 4;
        f32x4 v[8]; float ss = 0.f;
#pragma unroll
        for (int i = 0; i < 8; ++i) { v[i] = *(const f32x4*)(p + i * 256); ss += v[i][0] * v[i][0] + v[i][1] * v[i][1] + v[i][2] * v[i][2] + v[i][3] * v[i][3]; }
        ss = wave_sum(ss);
        const float rstd = rsqrtf(ss * (1.0f / DM) + EPS);
        bf16_t* o = dst + (size_t)row * DM + lane * 4;
#pragma unroll
        for (int i = 0; i < 8; ++i) {
            u32x2 w; w.x = cvt_pk_bf16(v[i][0] * rstd * g[i][0], v[i][1] * rstd * g[i][1]); w.y = cvt_pk_bf16(v[i][2] * rstd * g[i][2], v[i][3] * rstd * g[i][3]);
            *(u32x2*)(o + i * 256) = w;
            if (hi8) {
                float x0 = bf_lo(w.x) * 0.5f, x1 = bf_hi(w.x) * 0.5f, x2 = bf_lo(w.y) * 0.5f, x3 = bf_hi(w.y) * 0.5f;
#pragma unroll
                for (int t = 0; t < 4; ++t) {
                    unsigned p = 0u;
                    p = __builtin_amdgcn_cvt_scalef32_pk_fp4_f32(p, x0, x1, 1.0f, 0); p = __builtin_amdgcn_cvt_scalef32_pk_fp4_f32(p, x2, x3, 1.0f, 1);
                    *(unsigned short*)(hi8 + (size_t)t * NTOK * (DM / 2) + (size_t)row * (DM / 2) + i * 128 + lane * 2) = (unsigned short)p;
                    const f32x2 d01 = __builtin_amdgcn_cvt_scalef32_pk_f32_fp4(p, 1.0f, 0), d23 = __builtin_amdgcn_cvt_scalef32_pk_f32_fp4(p, 1.0f, 1);
                    x0 = (x0 - d01[0]) * 8.0f; x1 = (x1 - d01[1]) * 8.0f; x2 = (x2 - d23[0]) * 8.0f; x3 = (x3 - d23[1]) * 8.0f;
                }
            }
        }
    }
}
__device__ __forceinline__ void p0_prep(const Args& a, LAS unsigned char* lds) {
    unsigned char* ws = a.ws;
    LAS float* tile = (LAS float*)lds;
    transpose_cvt(a.in[2], DM, INC, (bf16_t*)(ws + WS_WIN), INP, tile);
    transpose_cvt(a.in[13], DM, DM, (bf16_t*)(ws + WS_WOUT), DM, tile);
    transpose_cvt(a.in[15], DM, DM, (bf16_t*)(ws + WS_WQ), DM, tile);
    transpose_cvt(a.in[4], 4096, 256, (bf16_t*)(ws + WS_CW1), 256, tile);
    transpose_cvt(a.in[6], 4096, 256, (bf16_t*)(ws + WS_CW1) + (size_t)256 * 4096, 256, tile);
    transpose_cvt(a.in[5], 256, 128, (bf16_t*)(ws + WS_CW2), 128, tile);
    transpose_cvt(a.in[7], 256, 128, (bf16_t*)(ws + WS_CW2) + (size_t)128 * 256, 128, tile);
    cvt_copy(a.in[16], (bf16_t*)(ws + WS_SUBK), (size_t)8 * 2 * 128 * 128);
    cvt_fp4(a.in[17], ws + WS_EU, (size_t)16384 * DM, 64.0f);
    cvt_fp4_vperm(a.in[18], ws + WS_EV, 2.8284271f);
    rms_rows(a.in[0], a.in[1], (bf16_t*)(ws + WS_A));
    __syncthreads();
    for (int o = blockIdx.x; o < 512; o += gridDim.x) {
        const int kv = o >> 8, n = o & 255; const float* w1 = a.in[kv ? 6 : 4]; const float* pe = a.in[3];
        float s = 0.f;
        for (int k = threadIdx.x; k < 4096; k += 512) s += pe[k] * w1[(size_t)k * 256 + n];
        s = wave_sum(s);
        if ((threadIdx.x & 63) == 0) tile[threadIdx.x >> 6] = s;
        __syncthreads();
        if (threadIdx.x == 0) { float t = 0.f; for (int i = 0; i < 8; ++i) t += tile[i]; ((float*)(ws + WS_CB))[o] = t; }
        __syncthreads();
    }
}

constexpr int KROW = 272, VROW = 144, KBUF = 64 * KROW, VBUF = 128 * VROW, ABUF = KBUF + VBUF;
struct Stage { u32x4 k[2], v[2]; };
__device__ __forceinline__ void stage_load(Stage& s, const bf16_t* kblk, size_t ldk, const bf16_t* vblk, size_t ldv, int tid) {
#pragma unroll
    for (int i = 0; i < 2; ++i) {
        const int id = tid + i * 512;
        s.k[i] = *(const u32x4*)(kblk + (size_t)(id >> 4) * ldk + (id & 15) * 8);
        s.v[i] = *(const u32x4*)(vblk + (size_t)(id >> 3) * ldv + (id & 7) * 8);
    }
}
__device__ __forceinline__ void stage_load_k(Stage& s, const bf16_t* kblk, size_t ldk, int tid) {
#pragma unroll
    for (int i = 0; i < 2; ++i) { const int id = tid + i * 512; s.k[i] = *(const u32x4*)(kblk + (size_t)(id >> 4) * ldk + (id & 15) * 8); }
}
__device__ __forceinline__ void stage_store(const Stage& s, LAS unsigned char* buf, int tid, bool withv) {
#pragma unroll
    for (int i = 0; i < 2; ++i) {
        const int id = tid + i * 512; const int kx = id >> 4;
        const int rho = ((kx >> 2) & 3) * 16 + (kx >> 4) * 4 + (kx & 3);
        *(LAS u32x4*)(buf + rho * KROW + (id & 15) * 16) = s.k[i];
        if (withv) *(LAS u32x4*)(buf + KBUF + (id >> 3) * VROW + (id & 7) * 16) = s.v[i];
    }
}
__device__ __forceinline__ void load_q(const bf16_t* qp, float scale, bf16x8 (&Bq)[4], int q) {
#pragma unroll
    for (int kk = 0; kk < 4; ++kk) {
        const u32x4 raw = *(const u32x4*)(qp + kk * 32 + q * 8);
        u32x4 w;
        w.x = cvt_pk_bf16(bf_lo(raw.x) * scale, bf_hi(raw.x) * scale); w.y = cvt_pk_bf16(bf_lo(raw.y) * scale, bf_hi(raw.y) * scale);
        w.z = cvt_pk_bf16(bf_lo(raw.z) * scale, bf_hi(raw.z) * scale); w.w = cvt_pk_bf16(bf_lo(raw.w) * scale, bf_hi(raw.w) * scale);
        Bq[kk] = as_bf16x8(w);
    }
}


__device__ __forceinline__ void qk_block2(const LAS unsigned char* Kl, const bf16x8 (&Bq)[2][4], f32x4 (&S)[2][4], int r, int q) {
    const LAS unsigned char* kp = Kl + r * KROW + q * 16;
    bf16x8 A[2][4];
#pragma unroll
    for (int kk = 0; kk < 4; ++kk) A[0][kk] = *(const LAS bf16x8*)(kp + kk * 64);
#pragma unroll
    for (int n = 0; n < 4; ++n) {
        if (n < 3) {
#pragma unroll
            for (int kk = 0; kk < 4; ++kk) A[(n + 1) & 1][kk] = *(const LAS bf16x8*)(kp + (n + 1) * 16 * KROW + kk * 64);
        }
        S[0][n] = (f32x4){0.f, 0.f, 0.f, 0.f}; S[1][n] = (f32x4){0.f, 0.f, 0.f, 0.f};
#pragma unroll
        for (int kk = 0; kk < 4; ++kk) { S[0][n] = MFMA16(A[n & 1][kk], Bq[0][kk], S[0][n]); S[1][n] = MFMA16(A[n & 1][kk], Bq[1][kk], S[1][n]); }
    }
}
__device__ __forceinline__ void pv_block2(const LAS unsigned char* Vl, const bf16x8 (&P)[2][2], f32x4 (&O)[2][8], int r, int q) {
    const LAS unsigned char* vp = Vl + r * VROW + q * 32;
    bf16x8 A[2][4];
#pragma unroll
    for (int i = 0; i < 4; ++i) A[0][i] = *(const LAS bf16x8*)(vp + (i >> 1) * 16 * VROW + (i & 1) * 16);
#pragma unroll
    for (int gi = 0; gi < 4; ++gi) {
        if (gi < 3) {
#pragma unroll
            for (int i = 0; i < 4; ++i) A[(gi + 1) & 1][i] = *(const LAS bf16x8*)(vp + ((gi + 1) * 2 + (i >> 1)) * 16 * VROW + (i & 1) * 16);
        }
#pragma unroll
        for (int i = 0; i < 4; ++i) {
            const int dt = gi * 2 + (i >> 1), m = i & 1;
            O[0][dt] = MFMA16(A[gi & 1][i], P[0][m], O[0][dt]); O[1][dt] = MFMA16(A[gi & 1][i], P[1][m], O[1][dt]);
        }
    }
}
__device__ __forceinline__ void pack_p4(const f32x4 (&a)[4], bf16x8 (&P)[2]) {
    u32x4 w0, w1;
    w0.x = cvt_pk_bf16(a[0][0], a[0][1]); w0.y = cvt_pk_bf16(a[0][2], a[0][3]); w0.z = cvt_pk_bf16(a[1][0], a[1][1]); w0.w = cvt_pk_bf16(a[1][2], a[1][3]);
    w1.x = cvt_pk_bf16(a[2][0], a[2][1]); w1.y = cvt_pk_bf16(a[2][2], a[2][3]); w1.z = cvt_pk_bf16(a[3][0], a[3][1]); w1.w = cvt_pk_bf16(a[3][2], a[3][3]);
    P[0] = as_bf16x8(w0); P[1] = as_bf16x8(w1);
}
__device__ __forceinline__ int next_ticket(unsigned* ctr, volatile LAS int* slot) {
    __syncthreads();
    if (threadIdx.x == 0) *slot = (int)__hip_atomic_fetch_add(ctr, 1u, __ATOMIC_RELAXED, __HIP_MEMORY_SCOPE_AGENT);
    __syncthreads();
    return *slot;
}
__device__ __forceinline__ unsigned ticket_request(unsigned* ctr) { return threadIdx.x == 0 ? __hip_atomic_fetch_add(ctr, 1u, __ATOMIC_RELAXED, __HIP_MEMORY_SCOPE_AGENT) : 0u; }
__device__ __forceinline__ int ticket_publish(unsigned v, volatile LAS int* slot) {
    __syncthreads();
    if (threadIdx.x == 0) *slot = (int)v;
    __syncthreads();
    return *slot;
}


__device__ __forceinline__ void sb_elementwise_robust(f32x4 (&S)[2][4], bf16x8 (&P)[2][2], float (&Prun)[2], int s0, int tw_lo, int r, int q) {
#pragma unroll
    for (int ct = 0; ct < 2; ++ct) {
        const int tq = tw_lo + ct * 16 + r;
        float e = 1.0f;
        if (s0 + 63 < tw_lo) {
#pragma unroll
            for (int i = 15; i >= 0; --i) {
                const float kp = frcp(1.0f + fexp2(S[ct][i >> 2][i & 3]));
                S[ct][i >> 2][i & 3] = (1.0f - kp) * e;
                e *= kp;
            }
        } else {
#pragma unroll
            for (int i = 15; i >= 0; --i) {
                const int s = s0 + 16 * q + i;
                const float kp = frcp(1.0f + fexp2(S[ct][i >> 2][i & 3]));
                const bool before = s < tq;
                S[ct][i >> 2][i & 3] = before ? (1.0f - kp) * e : 0.0f;
                e = before ? e * kp : e;
            }
        }
        const float a1 = __shfl_xor(e, 16), pp = e * a1, b1 = __shfl_xor(pp, 32);
        const float sfx = (q == 0) ? a1 * b1 : (q == 1) ? b1 : (q == 2) ? a1 : 1.0f;
        const float mult = sfx * Prun[ct];
        Prun[ct] *= pp * b1;
#pragma unroll
        for (int n = 0; n < 4; ++n) { S[ct][n][0] *= mult; S[ct][n][1] *= mult; S[ct][n][2] *= mult; S[ct][n][3] *= mult; }
        pack_p4(S[ct], P[ct]);
    }
}
__device__ __forceinline__ void sb_elementwise(f32x4 (&S)[2][4], bf16x8 (&P)[2][2], float (&Prun)[2], int s0, int tw_lo, int r, int q) {
    float mx = S[0][0][0];
#pragma unroll
    for (int ct = 0; ct < 2; ++ct)
#pragma unroll
        for (int n = 0; n < 4; ++n) mx = fmaxf(fmaxf(mx, fmaxf(S[ct][n][0], S[ct][n][1])), fmaxf(S[ct][n][2], S[ct][n][3]));
    if (__builtin_amdgcn_ballot_w64(!(mx <= 7.0f)) != 0ull) { sb_elementwise_robust(S, P, Prun, s0, tw_lo, r, q); return; }
#pragma unroll
    for (int ct = 0; ct < 2; ++ct) {
        const int tq = tw_lo + ct * 16 + r;
        float H = 1.0f;
        if (s0 + 63 < tw_lo) {
#pragma unroll
            for (int i = 0; i < 16; ++i) { const float t = fexp2(S[ct][i >> 2][i & 3]) * H; H += t; S[ct][i >> 2][i & 3] = t; }
        } else {
#pragma unroll
            for (int i = 0; i < 16; ++i) {
                const float x = (s0 + 16 * q + i < tq) ? fexp2(S[ct][i >> 2][i & 3]) : 0.0f;
                const float t = x * H; H += t; S[ct][i >> 2][i & 3] = t;
            }
        }
        const float e = frcp(H);
        const float a1 = __shfl_xor(e, 16), pp = e * a1, b1 = __shfl_xor(pp, 32);
        const float sfx = (q == 0) ? a1 * b1 : (q == 1) ? b1 : (q == 2) ? a1 : 1.0f;
        const float c = e * sfx * Prun[ct];
        Prun[ct] *= pp * b1;
#pragma unroll
        for (int n = 0; n < 4; ++n) { S[ct][n][0] *= c; S[ct][n][1] *= c; S[ct][n][2] *= c; S[ct][n][3] *= c; }
        pack_p4(S[ct], P[ct]);
    }
}
constexpr int KDB = 16384, VDB = 16384;
__device__ __forceinline__ void dma_kv_offsets(int tid, unsigned ldkB, unsigned ldvB, unsigned& koff, unsigned& voff) {
    const int w = tid >> 6, l = tid & 63;
    const int R = 4 * w + (l >> 4), p = l & 15;
    const int kx = ((R >> 2) & 3) * 16 + (R >> 4) * 4 + (R & 3);
    koff = (unsigned)kx * ldkB + (unsigned)((p ^ (R & 15)) * 16);
    const int d = 8 * w + (l >> 3), pv = l & 7;
    voff = (unsigned)d * ldvB + (unsigned)((pv ^ ((d >> 1) & 7)) * 16);
}
__device__ __forceinline__ void dma_k(const bf16_t* kblk, unsigned ldkB, unsigned koff, LAS unsigned char* dst, unsigned ldsw) {
#pragma unroll
    for (int i = 0; i < 2; ++i)
        __builtin_amdgcn_global_load_lds((const unsigned*)((const char*)kblk + koff + (size_t)i * 8 * ldkB), (LAS unsigned*)(dst + ldsw + i * 8192), 16, 0, 0);
}
__device__ __forceinline__ void dma_v(const bf16_t* vblk, unsigned ldvB, unsigned voff, LAS unsigned char* dst, unsigned ldsw) {
#pragma unroll
    for (int i = 0; i < 2; ++i)
        __builtin_amdgcn_global_load_lds((const unsigned*)((const char*)vblk + voff + (size_t)i * 64 * ldvB), (LAS unsigned*)(dst + ldsw + i * 8192), 16, 0, 0);
}
#define SGB_PIPE4x8() do { __builtin_amdgcn_sched_group_barrier(0x100, 4, 0); _Pragma("unroll") for (int g_ = 0; g_ < 3; ++g_) { _Pragma("unroll") for (int h_ = 0; h_ < 4; ++h_) { \
        __builtin_amdgcn_sched_group_barrier(0x008, 2, 0); __builtin_amdgcn_sched_group_barrier(0x100, 1, 0); } } __builtin_amdgcn_sched_group_barrier(0x008, 8, 0); } while (0)
__device__ __forceinline__ void qk_block2d(const LAS unsigned char* Kl, const bf16x8 (&Bq)[2][4], f32x4 (&S)[2][4], int r, int q) {
    const int base = r * 256 + ((q ^ (r & 3)) * 16), xk = (r >> 2) * 64;
    const LAS unsigned char* kp[4];
#pragma unroll
    for (int kk = 0; kk < 4; ++kk) kp[kk] = Kl + base + ((kk * 64) ^ xk);
    bf16x8 A[2][4];
#pragma unroll
    for (int kk = 0; kk < 4; ++kk) A[0][kk] = *(const LAS bf16x8*)(kp[kk]);
#pragma unroll
    for (int n = 0; n < 4; ++n) {
        if (n < 3) {
#pragma unroll
            for (int kk = 0; kk < 4; ++kk) A[(n + 1) & 1][kk] = *(const LAS bf16x8*)(kp[kk] + (n + 1) * 4096);
        }
        S[0][n] = (f32x4){0.f, 0.f, 0.f, 0.f}; S[1][n] = (f32x4){0.f, 0.f, 0.f, 0.f};
#pragma unroll
        for (int kk = 0; kk < 4; ++kk) { S[0][n] = MFMA16(A[n & 1][kk], Bq[0][kk], S[0][n]); S[1][n] = MFMA16(A[n & 1][kk], Bq[1][kk], S[1][n]); }
    }
    SGB_PIPE4x8();
}
__device__ __forceinline__ void pv_block2d(const LAS unsigned char* Vl, const bf16x8 (&P)[2][2], f32x4 (&O)[2][8], int r, int q) {
    const LAS unsigned char* vp[2];
#pragma unroll
    for (int m = 0; m < 2; ++m) vp[m] = Vl + r * 128 + (((q * 2 + m) ^ (r >> 1)) * 16);
    bf16x8 A[2][4];
#pragma unroll
    for (int i = 0; i < 4; ++i) A[0][i] = *(const LAS bf16x8*)(vp[i & 1] + (i >> 1) * 2048);
#pragma unroll
    for (int gi = 0; gi < 4; ++gi) {
        if (gi < 3) {
#pragma unroll
            for (int i = 0; i < 4; ++i) A[(gi + 1) & 1][i] = *(const LAS bf16x8*)(vp[i & 1] + ((gi + 1) * 2 + (i >> 1)) * 2048);
        }
#pragma unroll
        for (int i = 0; i < 4; ++i) {
            const int dt = gi * 2 + (i >> 1), m = i & 1;
            O[0][dt] = MFMA16(A[gi & 1][i], P[0][m], O[0][dt]); O[1][dt] = MFMA16(A[gi & 1][i], P[1][m], O[1][dt]);
        }
    }
    SGB_PIPE4x8();
}
__device__ __forceinline__ void sb_qblock4(const Args& a, int b, int h, int qb, LAS unsigned char* lds) {
    unsigned char* ws = a.ws;
    int tid_ = threadIdx.x; asm volatile("" : "+v"(tid_));
    const int tid = tid_, lane = tid & 63, wave = __builtin_amdgcn_readfirstlane(tid >> 6), r = lane & 15, q = lane >> 4;
    const int t0 = qb * 256, tw_lo = t0 + wave * 32, tw_hi = tw_lo + 31;
    bf16x8 Bq[2][4];
#pragma unroll
    for (int ct = 0; ct < 2; ++ct) load_q((const bf16_t*)(ws + WS_QSB) + (size_t)(b * NT + tw_lo + ct * 16 + r) * 1024 + h * 128, QSCALE, Bq[ct], q);
    const bf16_t* kbase = (const bf16_t*)(ws + WS_KSB) + (size_t)(b * 8 + h) * NT * 128;
    const bf16_t* vbase = (const bf16_t*)(ws + WS_VSBT) + (size_t)(b * 8 + h) * 64 * 8192;
    f32x4 O[2][8];
#pragma unroll
    for (int ct = 0; ct < 2; ++ct)
#pragma unroll
        for (int i = 0; i < 8; ++i) O[ct][i] = (f32x4){0.f, 0.f, 0.f, 0.f};
    float Prun[2] = {1.0f, 1.0f};
    const int nblk = 4 * qb + 4;
    LAS unsigned char* kb0 = lds; LAS unsigned char* vb0 = lds + 2 * KDB;
    unsigned koff, voff; dma_kv_offsets(tid, 256u, 128u, koff, voff);
    const unsigned ldsw = (unsigned)wave * 1024u;
    dma_k(kbase + (size_t)(nblk - 1) * 8192, 256u, koff, kb0, ldsw);
    dma_v(vbase + (size_t)(nblk - 1) * 8192, 128u, voff, vb0, ldsw);
    dma_k(kbase + (size_t)(nblk - 2) * 8192, 256u, koff, kb0 + KDB, ldsw);
    asm volatile("s_waitcnt vmcnt(0)" ::: "memory");
    __syncthreads();
    f32x4 S[2][4]; bf16x8 P[2][2];
#define SB_DMA(J) do { const int j_ = (J); \
        if (j_ + 2 < nblk) dma_k(kbase + (size_t)(nblk - 3 - j_) * 8192, 256u, koff, kb0 + (j_ & 1) * KDB, ldsw); \
        if (j_ + 1 < nblk) dma_v(vbase + (size_t)(nblk - 2 - j_) * 8192, 128u, voff, vb0 + ((j_ + 1) & 1) * VDB, ldsw); } while (0)
#define SB_EW(J) do { const int s0_ = (nblk - 1 - (J)) * 64; if (s0_ < tw_hi) sb_elementwise(S, P, Prun, s0_, tw_lo, r, q); } while (0)
#define SB_M(J) do { const int j_ = (J), s0_ = (nblk - 1 - j_) * 64; \
        if (s0_ < tw_hi) pv_block2d(vb0 + (j_ & 1) * VDB, P, O, r, q); \
        if (j_ + 1 < nblk && (s0_ - 64) < tw_hi) qk_block2d(kb0 + ((j_ + 1) & 1) * KDB, Bq, S, r, q); } while (0)
    if (wave < 4) {
        if ((nblk - 1) * 64 < tw_hi) qk_block2d(kb0, Bq, S, r, q);
        __syncthreads();
        for (int j = 0; j < nblk; ++j) {
            SB_EW(j);
            asm volatile("s_waitcnt vmcnt(0)" ::: "memory");
            __syncthreads();
            SB_DMA(j);
            SB_M(j);
            __syncthreads();
        }
        __syncthreads();
    } else {
        __syncthreads();
        if ((nblk - 1) * 64 < tw_hi) qk_block2d(kb0, Bq, S, r, q);
        __syncthreads();
        for (int j = 0; j < nblk; ++j) {
            SB_DMA(j);
            SB_EW(j);
            __syncthreads();
            SB_M(j);
            asm volatile("s_waitcnt vmcnt(0)" ::: "memory");
            __syncthreads();
        }
    }
#undef SB_DMA
#undef SB_EW
#undef SB_M
#pragma unroll
    for (int ct = 0; ct < 2; ++ct) {
        bf16_t* op = (bf16_t*)(ws + WS_ORAW) + (size_t)(b * NT + tw_lo + ct * 16 + r) * DM + h * 128 + q * 4;
#pragma unroll
        for (int dt = 0; dt < 8; ++dt) { u32x2 w; w.x = cvt_pk_bf16(O[ct][dt][0], O[ct][dt][1]); w.y = cvt_pk_bf16(O[ct][dt][2], O[ct][dt][3]); *(u32x2*)(op + dt * 16) = w; }
    }
}

__device__ __forceinline__ void compress_item(const Args& a, int item, LAS unsigned char* lds) {
    unsigned char* ws = a.ws;
    int tid_ = threadIdx.x; asm volatile("" : "+v"(tid_));
    const int tid = tid_, lane = tid & 63, wave = __builtin_amdgcn_readfirstlane(tid >> 6), r = lane & 15, q = lane >> 4;
    const int kv = item >> 6, bg = (item >> 2) & 15, cc = item & 3, b = bg >> 1, g = bg & 1;
    const bf16_t* X = (const bf16_t*)(ws + (kv ? WS_VCI : WS_KCI)) + (size_t)b * NT * 256 + g * 128;
    const bf16_t* W1 = (const bf16_t*)(ws + WS_CW1) + (size_t)kv * 256 * 4096;
    const bf16_t* W2 = (const bf16_t*)(ws + WS_CW2) + (size_t)kv * 128 * 256;
    const float* cb = (const float*)(ws + WS_CB) + kv * 256;
    constexpr int HROW = 528;
    LAS unsigned char* Hs = lds; LAS float* Os = (LAS float*)(lds + 64 * HROW);
    f32x4 acc[2][4];
#pragma unroll
    for (int i = 0; i < 2; ++i)
#pragma unroll
        for (int j = 0; j < 4; ++j) acc[i][j] = (f32x4){0.f, 0.f, 0.f, 0.f};
    const bf16_t* xr[4];
#pragma unroll
    for (int ct = 0; ct < 4; ++ct) { int c = cc * 64 + ct * 16 + r; c = c > 254 ? 254 : c; xr[ct] = X + (size_t)(16 * c) * 256 + q * 8; }
    const bf16_t* w1r0 = W1 + (size_t)(wave * 32 + r) * 4096 + q * 8;
    const bf16_t* w1r1 = w1r0 + (size_t)16 * 4096;
#pragma unroll 4
    for (int ks = 0; ks < 128; ++ks) {
        const int xo = (ks >> 2) * 256 + (ks & 3) * 32;
        const bf16x8 A0 = *(const bf16x8*)(w1r0 + ks * 32), A1 = *(const bf16x8*)(w1r1 + ks * 32);
#pragma unroll
        for (int ct = 0; ct < 4; ++ct) { const bf16x8 Bf = *(const bf16x8*)(xr[ct] + xo); acc[0][ct] = MFMA16(A0, Bf, acc[0][ct]); acc[1][ct] = MFMA16(A1, Bf, acc[1][ct]); }
    }
#pragma unroll
    for (int nt = 0; nt < 2; ++nt) {
        const int n0 = wave * 32 + nt * 16 + q * 4;
        const f32x4 bias = *(const f32x4*)(cb + n0);
#pragma unroll
        for (int ct = 0; ct < 4; ++ct) {
            const f32x4 v = acc[nt][ct] + bias;
            u32x2 w; w.x = cvt_pk_bf16(gelu_tanh(v[0]), gelu_tanh(v[1])); w.y = cvt_pk_bf16(gelu_tanh(v[2]), gelu_tanh(v[3]));
            *(LAS u32x2*)(Hs + (ct * 16 + r) * HROW + n0 * 2) = w;
        }
    }
    __syncthreads();
    f32x4 acc2[4];
#pragma unroll
    for (int j = 0; j < 4; ++j) acc2[j] = (f32x4){0.f, 0.f, 0.f, 0.f};
    const bf16_t* w2r = W2 + (size_t)(wave * 16 + r) * 256 + q * 8;
#pragma unroll
    for (int k2 = 0; k2 < 8; ++k2) {
        const bf16x8 A2 = *(const bf16x8*)(w2r + k2 * 32);
#pragma unroll
        for (int ct = 0; ct < 4; ++ct) { const bf16x8 B2 = *(const LAS bf16x8*)(Hs + (ct * 16 + r) * HROW + (k2 * 32 + q * 8) * 2); acc2[ct] = MFMA16(A2, B2, acc2[ct]); }
    }
#pragma unroll
    for (int ct = 0; ct < 4; ++ct) *(LAS f32x4*)(Os + (ct * 16 + r) * 132 + wave * 16 + q * 4) = acc2[ct];
    __syncthreads();
    {
        const int row = tid >> 3, part = tid & 7, c = cc * 64 + row;
        float v[16]; float ss = 0.f;
#pragma unroll
        for (int e = 0; e < 16; ++e) { v[e] = Os[row * 132 + part * 16 + e]; ss += v[e] * v[e]; }
        if (kv == 0) {
            ss += __shfl_xor(ss, 1); ss += __shfl_xor(ss, 2); ss += __shfl_xor(ss, 4);
            const float rstd = rsqrtf(ss * (1.0f / 128.0f) + EPS);
            const float* kg = a.in[9] + part * 16;
#pragma unroll
            for (int e = 0; e < 16; ++e) v[e] = (c == 255) ? 0.f : v[e] * rstd * kg[e];
            bf16_t* o = (bf16_t*)(ws + WS_KC) + ((size_t)bg * 256 + c) * 128 + part * 16;
            u32x4 w0, w1;
            w0.x = cvt_pk_bf16(v[0], v[1]); w0.y = cvt_pk_bf16(v[2], v[3]); w0.z = cvt_pk_bf16(v[4], v[5]); w0.w = cvt_pk_bf16(v[6], v[7]);
            w1.x = cvt_pk_bf16(v[8], v[9]); w1.y = cvt_pk_bf16(v[10], v[11]); w1.z = cvt_pk_bf16(v[12], v[13]); w1.w = cvt_pk_bf16(v[14], v[15]);
            *(u32x4*)o = w0; *(u32x4*)(o + 8) = w1;
        } else {
            bf16_t* o = (bf16_t*)(ws + WS_VCT) + ((size_t)bg * 128 + part * 16) * 256 + c;
#pragma unroll
            for (int e = 0; e < 16; ++e) { const float x = (c == 255) ? 0.f : v[e]; o[(size_t)e * 256] = (bf16_t)(cvt_pk_bf16(x, 0.f) & 0xffffu); }
        }
    }
    __syncthreads();
}

__device__ __forceinline__ void fixup_item(const Args& a, int item) {
    unsigned char* ws = a.ws;
    int tid_ = threadIdx.x; asm volatile("" : "+v"(tid_));
    const int tid = tid_, grp = tid >> 4, sub = tid & 15;
    f32x4 gq0 = *(const f32x4*)(a.in[8] + sub * 8), gq1 = *(const f32x4*)(a.in[8] + sub * 8 + 4);
    f32x4 gk0 = *(const f32x4*)(a.in[9] + sub * 8), gk1 = *(const f32x4*)(a.in[9] + sub * 8 + 4);
    for (int it = 0; it < 48; ++it) {
        const int hr = grp + it * 32, tok = item * 128 + hr / 12, hd = hr % 12;
        const bf16_t* p; bf16_t* po; f32x4 g0, g1; float sc;
        if (hd < 8) { const size_t o = (size_t)tok * 1024 + hd * 128 + sub * 8; p = (const bf16_t*)(ws + WS_QN) + o; po = (bf16_t*)(ws + WS_QN2) + o; g0 = gq0; g1 = gq1; sc = QSCALE; }
        else if (hd < 10) { const size_t o = (size_t)tok * 256 + (hd - 8) * 128 + sub * 8; p = (const bf16_t*)(ws + WS_KSL) + o; po = (bf16_t*)(ws + WS_KSL2) + ((size_t)((tok >> 12) * 2 + (hd - 8)) * NT + (tok & 4095)) * 128 + sub * 8; g0 = gk0; g1 = gk1; sc = 1.0f; }
        else { const size_t o = (size_t)tok * 256 + (hd - 10) * 128 + sub * 8; p = (const bf16_t*)(ws + WS_KWI) + o; po = (bf16_t*)(ws + WS_KWI2) + ((size_t)((tok >> 12) * 2 + (hd - 10)) * NT + (tok & 4095)) * 128 + sub * 8; g0 = gk0; g1 = gk1; sc = 1.0f; }
        const u32x4 raw = *(const u32x4*)p;
        float f[8] = {bf_lo(raw.x), bf_hi(raw.x), bf_lo(raw.y), bf_hi(raw.y), bf_lo(raw.z), bf_hi(raw.z), bf_lo(raw.w), bf_hi(raw.w)};
        float ss = 0.f;
#pragma unroll
        for (int e = 0; e < 8; ++e) ss += f[e] * f[e];
        ss += __shfl_xor(ss, 1); ss += __shfl_xor(ss, 2); ss += __shfl_xor(ss, 4); ss += __shfl_xor(ss, 8);
        const float rstd = rsqrtf(ss * (1.0f / 128.0f) + EPS) * sc;
        u32x4 w;
        w.x = cvt_pk_bf16(f[0] * rstd * g0[0], f[1] * rstd * g0[1]); w.y = cvt_pk_bf16(f[2] * rstd * g0[2], f[3] * rstd * g0[3]);
        w.z = cvt_pk_bf16(f[4] * rstd * g1[0], f[5] * rstd * g1[1]); w.w = cvt_pk_bf16(f[6] * rstd * g1[2], f[7] * rstd * g1[3]);
        *(u32x4*)po = w;
    }
}

enum { MODE_CMP = 0, MODE_SLC = 1, MODE_WIN = 2 };

constexpr int NS2_IMP = 2 * ABUF;
constexpr int NS2_SEL = NS2_IMP + 64 * 65 * 4;
constexpr int NS2_LUT = NS2_SEL + 64 * 2 * 4;
constexpr int NS2_TKT = NS2_LUT + 4 * 256 * 4;

template <int MODE>
__device__ __forceinline__ void score_tile2(f32x4 (&S)[4], int tq, int idx0, int q, bool selok, const LAS float* lut) {
#pragma unroll
    for (int n = 0; n < 4; ++n)
#pragma unroll
        for (int j = 0; j < 4; ++j) {
            const int s = idx0 + 16 * q + 4 * n + j;
            int dist; bool valid;
            if (MODE == MODE_CMP) { dist = tq - (16 * s + 31); valid = dist >= 0; }
            else if (MODE == MODE_SLC) { dist = tq - s; valid = selok && dist >= 0; }
            else { dist = tq - s; valid = dist >= 0 && dist < 512; }
            int di = dist < 0 ? 0 : dist; di = di > 128 ? 128 : di;
            const float v = S[n][j] + lut[di];
            S[n][j] = valid ? v : -INFINITY;
        }
}
__device__ __forceinline__ void score_near(f32x4 (&S)[4], int D0, bool selok, const LAS float* lut) {
    const LAS float* eb = lut + (D0 - 15);
    const int dl = selok ? D0 : -1;
#pragma unroll
    for (int i = 0; i < 16; ++i) { const float v = S[i >> 2][i & 3] + eb[15 - i]; S[i >> 2][i & 3] = (i <= dl) ? v : -INFINITY; }
}
__device__ __forceinline__ void score_edge(f32x4 (&S)[4], int D0, float cb) {
    const int lim = D0 - 512;
#pragma unroll
    for (int i = 0; i < 16; ++i) { const float v = S[i >> 2][i & 3] + cb; S[i >> 2][i & 3] = (i > lim) ? v : -INFINITY; }
}
__device__ __forceinline__ float online_stats(f32x4 (&S)[4], float& m, float& l) {
    float mx = -INFINITY;
#pragma unroll
    for (int n = 0; n < 4; ++n) mx = fmaxf(fmaxf(mx, fmaxf(S[n][0], S[n][1])), fmaxf(S[n][2], S[n][3]));
    mx = row4_max_f32(mx);
    const float mnew = fmaxf(m, mx);
    const float msafe = (mnew == -INFINITY) ? 0.0f : mnew;
    const float alpha = fexp2(m - msafe);
    float rs = 0.f;
#pragma unroll
    for (int n = 0; n < 4; ++n)
#pragma unroll
        for (int j = 0; j < 4; ++j) { const float p = fexp2(S[n][j] - msafe); S[n][j] = p; rs += p; }
    rs = row4_sum_f32(rs);
    l = l * alpha + rs; m = mnew;
    return alpha;
}

__device__ __forceinline__ float online_stats_far(f32x4 (&S)[4], float& m, float& l, float cb, bool selok) {
    float mx = -INFINITY;
#pragma unroll
    for (int n = 0; n < 4; ++n) mx = fmaxf(fmaxf(mx, fmaxf(S[n][0], S[n][1])), fmaxf(S[n][2], S[n][3]));
    mx = row4_max_f32(mx);
    const float mnew = selok ? fmaxf(m, mx + cb) : m;
    const float msafe = (mnew == -INFINITY) ? 0.0f : mnew;
    const float alpha = fexp2(m - msafe);
    const float off = selok ? cb - msafe : -INFINITY;
    float rs = 0.f;
#pragma unroll
    for (int n = 0; n < 4; ++n)
#pragma unroll
        for (int j = 0; j < 4; ++j) { const float p = fexp2(S[n][j] + off); S[n][j] = p; rs += p; }
    rs = row4_sum_f32(rs);
    l = l * alpha + rs; m = mnew;
    return alpha;
}
__device__ __forceinline__ void nsa_probs(f32x4 (&S)[4], float& l, float mref, bool keep, bf16x8 (&P)[2]) {
    if (__builtin_amdgcn_ballot_w64(mref != 0.0f) != 0ull) {
#pragma unroll
        for (int n = 0; n < 4; ++n) { S[n][0] -= mref; S[n][1] -= mref; S[n][2] -= mref; S[n][3] -= mref; }
    }
    float rs = 0.f;
#pragma unroll
    for (int n = 0; n < 4; ++n)
#pragma unroll
        for (int j = 0; j < 4; ++j) { const float p = fexp2(S[n][j]); S[n][j] = p; rs += p; }
    pack_p4(S, P);
    if (!keep) { const bf16x8 z = {0, 0, 0, 0, 0, 0, 0, 0}; P[0] = z; P[1] = z; rs = 0.f; }
    l += rs;
}
__device__ __forceinline__ void nsa_flush(bf16_t* op0, bf16_t* op1, f32x4 (&O)[2][8], const float (&sc)[2], bool first) {
#pragma unroll
    for (int ct = 0; ct < 2; ++ct) {
        bf16_t* op = ct ? op1 : op0;
#pragma unroll
        for (int dt = 0; dt < 8; ++dt) {
            float v0 = sc[ct] * O[ct][dt][0], v1 = sc[ct] * O[ct][dt][1], v2 = sc[ct] * O[ct][dt][2], v3 = sc[ct] * O[ct][dt][3];
            if (!first) { const u32x2 old = *(const u32x2*)(op + dt * 16); v0 += bf_lo(old.x); v1 += bf_hi(old.x); v2 += bf_lo(old.y); v3 += bf_hi(old.y); }
            u32x2 w; w.x = cvt_pk_bf16(v0, v1); w.y = cvt_pk_bf16(v2, v3);
            *(u32x2*)(op + dt * 16) = w;
        }
    }
}

__device__ __forceinline__ void nsa_item2(const Args& a, int item, LAS unsigned char* lds) {
    unsigned char* ws = a.ws;
    int tid_ = threadIdx.x; asm volatile("" : "+v"(tid_));
    const int tid = tid_, lane = tid & 63, wave = __builtin_amdgcn_readfirstlane(tid >> 6), r = lane & 15, q = lane >> 4;
    const int b = item >> 7, g = (item >> 6) & 1, qi = item & 63;
    const int hr = wave >> 1, qh = wave & 1;
    const int t0 = qi * 64, cur = qi, tw = t0 + qh * 32;
    const int bg = b * 2 + g;
    LAS unsigned* imp = (LAS unsigned*)(lds + NS2_IMP);
    LAS unsigned* sel = (LAS unsigned*)(lds + NS2_SEL);
    LAS float* lutall = (LAS float*)(lds + NS2_LUT);
    for (int i = tid; i < 4 * 256; i += 512) {
        const int hh = i >> 8, dr = (i & 255) - 64, d = dr < 0 ? 0 : dr;
        int bucket;
        if (d < 16) bucket = d;
        else { const int lg = (int)(__log2f((float)d * (1.0f / 16.0f)) * (16.0f / 3.0f)); bucket = 16 + lg; bucket = bucket > 31 ? 31 : bucket; }
        if (d >= 128) bucket = 31;
        lutall[i] = (a.in[10][bucket * 8 + g * 4 + hh] - a.in[10][31 * 8 + g * 4 + hh]) * LOG2E;
    }
    for (int i = tid; i < 64 * 65; i += 512) imp[i] = 0u;
    if (tid < 128) sel[tid] = 0u;
    const LAS float* lut = lutall + hr * 256 + 64;
    bf16x8 Bq[2][4];
    float gate[2][3];
    bf16_t* op[2];
#pragma unroll
    for (int ct = 0; ct < 2; ++ct) {
        const size_t row = (size_t)(b * NT + tw + ct * 16 + r);
        load_q((const bf16_t*)(ws + WS_QN2) + row * 1024 + (g * 4 + hr) * 128, 1.0f, Bq[ct], q);
        const bf16_t* gp = (const bf16_t*)(ws + WS_GT) + row * 32 + g * 12 + hr * 3;
#pragma unroll
        for (int i = 0; i < 3; ++i) { const float x = __uint_as_float(((unsigned)gp[i]) << 16); gate[ct][i] = frcp(1.0f + fexp2(-x * LOG2E)); }
        op[ct] = (bf16_t*)(ws + WS_ORAW) + row * DM + 1024 + (g * 4 + hr) * 128 + q * 4;
    }
    f32x4 O[2][8];
    Stage st;
    __syncthreads();
    float mref[2];
    {
        float gm = fmaxf(fabsf(a.in[9][lane * 2]), fabsf(a.in[9][lane * 2 + 1]));
        float bm = 0.f;
        for (int d = lane; d <= 128; d += 64) bm = fmaxf(bm, lut[d]);
#pragma unroll
        for (int o = 32; o > 0; o >>= 1) { gm = fmaxf(gm, __shfl_xor(gm, o)); bm = fmaxf(bm, __shfl_xor(bm, o)); }
#pragma unroll
        for (int ct = 0; ct < 2; ++ct) {
            float ss = 0.f;
#pragma unroll
            for (int kk = 0; kk < 4; ++kk) {
                const u32x4 w = __builtin_bit_cast(u32x4, Bq[ct][kk]);
                ss += bf_lo(w.x) * bf_lo(w.x) + bf_hi(w.x) * bf_hi(w.x) + bf_lo(w.y) * bf_lo(w.y) + bf_hi(w.y) * bf_hi(w.y)
                    + bf_lo(w.z) * bf_lo(w.z) + bf_hi(w.z) * bf_hi(w.z) + bf_lo(w.w) * bf_lo(w.w) + bf_hi(w.w) * bf_hi(w.w);
            }
            ss = row4_sum_f32(ss);
            mref[ct] = fmaxf(0.0f, sqrtf(ss) * 11.3137085f * gm * 1.01f + bm - 64.0f);
        }
    }
    {
        const bf16_t* kbase = (const bf16_t*)(ws + WS_KC) + (size_t)bg * 256 * 128;
        const bf16_t* vbase = (const bf16_t*)(ws + WS_VCT) + (size_t)bg * 128 * 256;
        const int ncb = ((t0 + 32) >> 4) / 64 + 1;
        float m[2] = {-INFINITY, -INFINITY}, l[2] = {0.f, 0.f};
        stage_load_k(st, kbase, 128, tid); stage_store(st, lds, tid, false); __syncthreads();
        for (int it = 0; it < ncb; ++it) {
            const LAS unsigned char* buf = lds + (it & 1) * ABUF;
            if (it + 1 < ncb) stage_load_k(st, kbase + (size_t)(it + 1) * 8192, 128, tid);
            f32x4 S[2][4]; qk_block2(buf, Bq, S, r, q);
#pragma unroll
            for (int ct = 0; ct < 2; ++ct) {
                if (tw >= 1024 * it + 1167) (void)online_stats_far(S[ct], m[ct], l[ct], lut[128], true);
                else { score_tile2<MODE_CMP>(S[ct], tw + ct * 16 + r, it * 64, q, true, lut); (void)online_stats(S[ct], m[ct], l[ct]); }
            }
            if (it + 1 < ncb) stage_store(st, lds + ((it + 1) & 1) * ABUF, tid, false);
            __syncthreads();
        }
        float msafe[2], invl[2];
#pragma unroll
        for (int ct = 0; ct < 2; ++ct) { msafe[ct] = (m[ct] == -INFINITY) ? 0.0f : m[ct]; invl[ct] = l[ct] > 0.f ? frcp(l[ct]) : 0.f; }
#pragma unroll
        for (int ct = 0; ct < 2; ++ct)
#pragma unroll
            for (int i = 0; i < 8; ++i) O[ct][i] = (f32x4){0.f, 0.f, 0.f, 0.f};
        stage_load(st, kbase, 128, vbase, 256, tid); stage_store(st, lds, tid, true); __syncthreads();
        for (int it = 0; it < ncb; ++it) {
            const LAS unsigned char* buf = lds + (it & 1) * ABUF;
            if (it + 1 < ncb) stage_load(st, kbase + (size_t)(it + 1) * 8192, 128, vbase + (it + 1) * 64, 256, tid);
            f32x4 S[2][4]; qk_block2(buf, Bq, S, r, q);
            bf16x8 P[2][2];
#pragma unroll
            for (int ct = 0; ct < 2; ++ct) {
                const bool farb = tw >= 1024 * it + 1167;
                if (!farb) score_tile2<MODE_CMP>(S[ct], tw + ct * 16 + r, it * 64, q, true, lut);
                const float offc = (farb ? lut[128] : 0.0f) - msafe[ct];
#pragma unroll
                for (int n = 0; n < 4; ++n) {
#pragma unroll
                    for (int j = 0; j < 4; ++j) S[ct][n][j] = fexp2(S[ct][n][j] + offc) * invl[ct];
                    const int nsel = it * 16 + 4 * q + n;
                    const float aa = S[ct][n][0] + S[ct][n][1] + S[ct][n][2] + 0.5f * S[ct][n][3], bb = 0.5f * S[ct][n][3];
                    LAS unsigned* ip = imp + (qh * 32 + ct * 16 + r) * 65 + nsel;
                    __hip_atomic_fetch_add(ip, (unsigned)(aa * 16777216.0f + 0.5f), __ATOMIC_RELAXED, __HIP_MEMORY_SCOPE_WORKGROUP);
                    __hip_atomic_fetch_add(ip + 1, (unsigned)(bb * 16777216.0f + 0.5f), __ATOMIC_RELAXED, __HIP_MEMORY_SCOPE_WORKGROUP);
                }
                pack_p4(S[ct], P[ct]);
            }
            pv_block2(buf + KBUF, P, O, r, q);
            if (it + 1 < ncb) stage_store(st, lds + ((it + 1) & 1) * ABUF, tid, true);
            __syncthreads();
        }
        const float sc[2] = {gate[0][0], gate[1][0]};
        nsa_flush(op[0], op[1], O, sc, true);
    }
    {
        const int qx = tid >> 3, tl = tid & 7;
        unsigned lo = 0u, hi = 0u;
        if (cur <= 15) { if (tl == 0) lo = (2u << cur) - 1u; }
        else {
            const LAS unsigned* iq = imp + qx * 65;
            for (int n = 1 + tl; n <= cur - 2; n += 8) {
                const unsigned v = iq[n]; int rank = 0;
                for (int mm = 1; mm <= cur - 2; ++mm) { const unsigned w = iq[mm]; rank += (w > v || (w == v && mm < n)) ? 1 : 0; }
                if (rank < 13) { if (n < 32) lo |= 1u << n; else hi |= 1u << (n - 32); }
            }
            if (tl == 0) { lo |= 1u; if (cur < 32) lo |= 1u << cur; else hi |= 1u << (cur - 32); if (cur - 1 < 32) lo |= 1u << (cur - 1); else hi |= 1u << (cur - 33); }
        }
        if (lo) __hip_atomic_fetch_or(sel + qx * 2, lo, __ATOMIC_RELAXED, __HIP_MEMORY_SCOPE_WORKGROUP);
        if (hi) __hip_atomic_fetch_or(sel + qx * 2 + 1, hi, __ATOMIC_RELAXED, __HIP_MEMORY_SCOPE_WORKGROUP);
    }
    __syncthreads();
    {
        unsigned ulo = 0u, uhi = 0u;
        for (int i = 0; i < 64; ++i) { ulo |= sel[i * 2]; uhi |= sel[i * 2 + 1]; }
        unsigned long long rem = ((unsigned long long)__builtin_amdgcn_readfirstlane(uhi) << 32) | (unsigned long long)__builtin_amdgcn_readfirstlane(ulo);
        unsigned long long myq[2];
#pragma unroll
        for (int ct = 0; ct < 2; ++ct) myq[ct] = ((unsigned long long)sel[(qh * 32 + ct * 16 + r) * 2 + 1] << 32) | (unsigned long long)sel[(qh * 32 + ct * 16 + r) * 2];
        const bf16_t* kbase = (const bf16_t*)(ws + WS_KSL2) + (size_t)bg * NT * 128;
        const bf16_t* vbase = (const bf16_t*)(ws + WS_VSLT) + (size_t)bg * 64 * 8192;
        float l[2] = {0.f, 0.f};
#pragma unroll
        for (int ct = 0; ct < 2; ++ct)
#pragma unroll
            for (int i = 0; i < 8; ++i) O[ct][i] = (f32x4){0.f, 0.f, 0.f, 0.f};
        int jb = __builtin_ctzll(rem); rem &= rem - 1;
        stage_load(st, kbase + (size_t)jb * 8192, 128, vbase + (size_t)jb * 8192, 64, tid); stage_store(st, lds, tid, true); __syncthreads();
        for (int it = 0;; ++it) {
            const LAS unsigned char* buf = lds + (it & 1) * ABUF;
            const bool more = rem != 0ull;
            int jn = 0;
            if (more) { jn = __builtin_ctzll(rem); rem &= rem - 1; stage_load(st, kbase + (size_t)jn * 8192, 128, vbase + (size_t)jn * 8192, 64, tid); }
            f32x4 S[2][4]; qk_block2(buf, Bq, S, r, q);
            bf16x8 P[2][2];
            if (jb + 3 <= cur) {
#pragma unroll
                for (int ct = 0; ct < 2; ++ct) nsa_probs(S[ct], l[ct], mref[ct], ((myq[ct] >> jb) & 1ull) != 0ull, P[ct]);
            } else {
#pragma unroll
                for (int ct = 0; ct < 2; ++ct) { score_near(S[ct], tw + ct * 16 + r - jb * 64 - 16 * q, ((myq[ct] >> jb) & 1ull) != 0ull, lut); nsa_probs(S[ct], l[ct], mref[ct], true, P[ct]); }
            }
            pv_block2(buf + KBUF, P, O, r, q);
            if (more) stage_store(st, lds + ((it + 1) & 1) * ABUF, tid, true);
            __syncthreads();
            if (!more) break;
            jb = jn;
        }
        const float lt0 = row4_sum_f32(l[0]), lt1 = row4_sum_f32(l[1]);
        const float sc[2] = {gate[0][1] * (lt0 > 0.f ? frcp(lt0) : 0.f), gate[1][1] * (lt1 > 0.f ? frcp(lt1) : 0.f)};
        nsa_flush(op[0], op[1], O, sc, false);
    }
    {
        const bf16_t* kbase = (const bf16_t*)(ws + WS_KWI2) + (size_t)bg * NT * 128;
        const bf16_t* vbase = (const bf16_t*)(ws + WS_VWIT) + (size_t)bg * 64 * 8192;
        const int jlo = cur > 8 ? cur - 8 : 0;
        const int nblk = cur - jlo + 1;
        float l[2] = {0.f, 0.f};
#pragma unroll
        for (int ct = 0; ct < 2; ++ct)
#pragma unroll
            for (int i = 0; i < 8; ++i) O[ct][i] = (f32x4){0.f, 0.f, 0.f, 0.f};
        stage_load(st, kbase + (size_t)jlo * 8192, 128, vbase + (size_t)jlo * 8192, 64, tid); stage_store(st, lds, tid, true); __syncthreads();
        for (int it = 0; it < nblk; ++it) {
            const LAS unsigned char* buf = lds + (it & 1) * ABUF;
            if (it + 1 < nblk) stage_load(st, kbase + (size_t)(jlo + it + 1) * 8192, 128, vbase + (size_t)(jlo + it + 1) * 8192, 64, tid);
            f32x4 S[2][4]; qk_block2(buf, Bq, S, r, q);
            bf16x8 P[2][2];
            const int jw = jlo + it;
            if (!(jw + 3 <= cur && jw + 8 > cur)) {
#pragma unroll
                for (int ct = 0; ct < 2; ++ct) {
                    const int D0 = tw + ct * 16 + r - jw * 64 - 16 * q;
                    if (jw + 3 > cur) score_near(S[ct], D0, true, lut); else score_edge(S[ct], D0, lut[128]);
                }
            }
#pragma unroll
            for (int ct = 0; ct < 2; ++ct) nsa_probs(S[ct], l[ct], mref[ct], true, P[ct]);
            pv_block2(buf + KBUF, P, O, r, q);
            if (it + 1 < nblk) stage_store(st, lds + ((it + 1) & 1) * ABUF, tid, true);
            __syncthreads();
        }
        const float lt0 = row4_sum_f32(l[0]), lt1 = row4_sum_f32(l[1]);
        const float sc[2] = {gate[0][2] * (lt0 > 0.f ? frcp(lt0) : 0.f), gate[1][2] * (lt1 > 0.f ? frcp(lt1) : 0.f)};
        nsa_flush(op[0], op[1], O, sc, false);
    }
    __syncthreads();
}

__device__ __forceinline__ void norm_mixed(const Args& a) {
    unsigned char* ws = a.ws;
    const int lane = threadIdx.x & 63, wave = threadIdx.x >> 6;
    const bf16_t* src = (const bf16_t*)(ws + WS_ORAW); bf16_t* dst = (bf16_t*)(ws + WS_A);
    for (int row = blockIdx.x * 8 + wave; row < NTOK; row += gridDim.x * 8) {
#pragma unroll
        for (int half = 0; half < 2; ++half) {
            const bf16_t* p = src + (size_t)row * DM + half * 1024 + lane * 8;
            const float* gn = a.in[half ? 12 : 11] + lane * 8;
            u32x4 raw[2]; float f[16]; float ss = 0.f;
#pragma unroll
            for (int i = 0; i < 2; ++i) {
                raw[i] = *(const u32x4*)(p + i * 512);
                f[i * 8 + 0] = bf_lo(raw[i].x); f[i * 8 + 1] = bf_hi(raw[i].x); f[i * 8 + 2] = bf_lo(raw[i].y); f[i * 8 + 3] = bf_hi(raw[i].y);
                f[i * 8 + 4] = bf_lo(raw[i].z); f[i * 8 + 5] = bf_hi(raw[i].z); f[i * 8 + 6] = bf_lo(raw[i].w); f[i * 8 + 7] = bf_hi(raw[i].w);
            }
#pragma unroll
            for (int e = 0; e < 16; ++e) ss += f[e] * f[e];
            ss = wave_sum(ss);
            const float rstd = rsqrtf(ss * (1.0f / 1024.0f) + EPS);
#pragma unroll
            for (int i = 0; i < 2; ++i) {
                const f32x4 g0 = *(const f32x4*)(gn + i * 512), g1 = *(const f32x4*)(gn + i * 512 + 4);
                u32x4 w;
                w.x = cvt_pk_bf16(f[i * 8 + 0] * rstd * g0[0], f[i * 8 + 1] * rstd * g0[1]); w.y = cvt_pk_bf16(f[i * 8 + 2] * rstd * g0[2], f[i * 8 + 3] * rstd * g0[3]);
                w.z = cvt_pk_bf16(f[i * 8 + 4] * rstd * g1[0], f[i * 8 + 5] * rstd * g1[1]); w.w = cvt_pk_bf16(f[i * 8 + 6] * rstd * g1[2], f[i * 8 + 7] * rstd * g1[3]);
                *(u32x4*)(dst + (size_t)row * DM + half * 1024 + lane * 8 + i * 512) = w;
            }
        }
    }
}

__device__ __forceinline__ constexpr int cand_i(int c) {
    return c < 16 ? 0 : c < 24 ? 1 : c < 29 ? 2 : c < 33 ? 3 : c < 36 ? 4 : c < 38 ? 5 : c < 40 ? 6 : c < 42 ? 7 : (c - 42 + 8);
}
__device__ __forceinline__ constexpr int cand_j(int c) {
    return c < 16 ? c : c < 24 ? c - 16 : c < 29 ? c - 24 : c < 33 ? c - 29 : c < 36 ? c - 33 : c < 38 ? c - 36 : c < 40 ? c - 38 : c < 42 ? c - 40 : 0;
}
__device__ __forceinline__ void peer_topk_task(const Args& a, int tile, int tg, int h, LAS unsigned char* lds, int lane_in) {
    unsigned char* ws = a.ws;
    int lane = lane_in; asm volatile("" : "+v"(lane));
    const int r = lane & 15, q = lane >> 4;
    const int tok = tile * 64 + tg * 16 + r;
    unsigned tsu[2][16];
#pragma unroll
    for (int p = 0; p < 2; ++p) {
        const bf16_t* qp = (const bf16_t*)(ws + WS_QP) + (size_t)tok * DM + h * 256 + p * 128 + q * 8;
        const bf16_t* kp = (const bf16_t*)(ws + WS_SUBK) + ((size_t)(h * 2 + p) * 128 + r) * 128 + q * 8;
        bf16x8 Bq[4];
#pragma unroll
        for (int kk = 0; kk < 4; ++kk) Bq[kk] = *(const bf16x8*)(qp + kk * 32);
        unsigned u[32];
#pragma unroll
        for (int kt = 0; kt < 8; ++kt) {
            f32x4 acc = (f32x4){0.f, 0.f, 0.f, 0.f};
#pragma unroll
            for (int kk = 0; kk < 4; ++kk) { const bf16x8 A = *(const bf16x8*)(kp + (size_t)kt * 16 * 128 + kk * 32); acc = MFMA16(A, Bq[kk], acc); }
#pragma unroll
            for (int j = 0; j < 4; ++j) u[kt * 4 + j] = (f2sort(acc[j]) & ~127u) | (unsigned)(127 - (kt * 16 + q * 4 + j));
        }
        bitonic_sort_desc<16, 32>(u, 0); bitonic_sort_desc<16, 32>(u, 16);
        unsigned t16[16];
#pragma unroll
        for (int i = 0; i < 16; ++i) t16[i] = u[i] > u[31 - i] ? u[i] : u[31 - i];
        bitonic_merge_desc<16>(t16);
#pragma unroll
        for (int st = 0; st < 2; ++st) {
            unsigned o16[16];
#pragma unroll
            for (int i = 0; i < 16; ++i) { const unsigned pv = st == 0 ? partner32(t16[15 - i], lane) : partner16(t16[15 - i], lane); o16[i] = t16[i] > pv ? t16[i] : pv; }
            bitonic_merge_desc<16>(o16);
#pragma unroll
            for (int i = 0; i < 16; ++i) t16[i] = o16[i];
        }
#pragma unroll
        for (int it = 0; it < 16; ++it) tsu[p][it] = t16[it];
    }
    unsigned cu[13]; int ce[13];
#pragma unroll
    for (int uu = 0; uu < 13; ++uu) {
        unsigned key = 0u; int ex = 0;
#pragma unroll
        for (int qq = 0; qq < 4; ++qq) {
            const int c = 4 * uu + qq;
            if (c < 50) {
                const int ci = cand_i(c), cj = cand_j(c);
                const float sum = sort2f(tsu[0][ci] & ~127u) + sort2f(tsu[1][cj] & ~127u);
                const unsigned k2 = (f2sort(sum) & ~255u) | (unsigned)(255 - (ci * 16 + cj));
                const int e = (127 - (int)(tsu[0][ci] & 127u)) * 128 + (127 - (int)(tsu[1][cj] & 127u));
                if (q == qq) { key = k2; ex = e; }
            }
        }
        cu[uu] = key; ce[uu] = ex;
    }
    float bs[16]; int be[16];
#pragma unroll
    for (int it = 0; it < 16; ++it) {
        unsigned m = cu[0];
#pragma unroll
        for (int uu = 1; uu < 13; ++uu) m = cu[uu] > m ? cu[uu] : m;
        m = row4_max_u32(m);
        unsigned bx = 0u;
#pragma unroll
        for (int uu = 0; uu < 13; ++uu) { const bool hit = cu[uu] == m; bx = hit ? (unsigned)ce[uu] : bx; cu[uu] = hit ? 0u : cu[uu]; }
        bx = row4_max_u32(bx);
        bs[it] = sort2f(m & ~255u); be[it] = (int)bx;
    }
    float ex[16], sum = 0.f;
#pragma unroll
    for (int k = 0; k < 16; ++k) { ex[k] = fexp2((bs[k] - bs[0]) * LOG2E); sum += ex[k]; }
    const float inv = frcp(sum);
    if (q == 0) {
        int* ei = (int*)(ws + WS_PEI) + (size_t)tok * 128 + h * 16;
        float* wg = (float*)(ws + WS_PWG) + (size_t)tok * 128 + h * 16;
#pragma unroll
        for (int k4 = 0; k4 < 4; ++k4) {
            *(u32x4*)(ei + k4 * 4) = (u32x4){(unsigned)be[k4 * 4], (unsigned)be[k4 * 4 + 1], (unsigned)be[k4 * 4 + 2], (unsigned)be[k4 * 4 + 3]};
            *(f32x4*)(wg + k4 * 4) = (f32x4){ex[k4 * 4] * inv, ex[k4 * 4 + 1] * inv, ex[k4 * 4 + 2] * inv, ex[k4 * 4 + 3] * inv};
        }
    }
}
__device__ __forceinline__ float dpp_xor1(float v) { return __int_as_float(__builtin_amdgcn_update_dpp(0, __float_as_int(v), 0xB1, 0xf, 0xf, false)); }
__device__ __forceinline__ float dpp_xor2(float v) { return __int_as_float(__builtin_amdgcn_update_dpp(0, __float_as_int(v), 0x4E, 0xf, 0xf, false)); }
__device__ __forceinline__ float dpp_hmirror(float v) { return __int_as_float(__builtin_amdgcn_update_dpp(0, __float_as_int(v), 0x141, 0xf, 0xf, false)); }
constexpr int PEER_UNIT = 512;
typedef int i32x8 __attribute__((ext_vector_type(8)));
typedef int i32x4 __attribute__((ext_vector_type(4)));
__device__ __forceinline__ void peer_u_unit_m(const Args& a, int s, int chunk, LAS unsigned char* lds) {
    unsigned char* ws = a.ws;
    int tid_ = threadIdx.x; asm volatile("" : "+v"(tid_));
    const int lane = tid_ & 63, wave = __builtin_amdgcn_readfirstlane(tid_ >> 6), sub = lane >> 3, c8 = lane & 7, r = lane & 15, q = lane >> 4;
    const unsigned char* EU = ws + WS_EU + (size_t)s * 16384 * 128 + c8 * 16;
    const int tbase = chunk * PEER_UNIT + wave * (PEER_UNIT / 8);
    const int* ep0 = (const int*)(ws + WS_PEI) + sub * 16;
    const unsigned char* hb = ws + WS_H4 + (size_t)(r & 3) * NTOK * (DM / 2) + s * 128 + q * 16;
    float* slab = (float*)(ws + WS_SLAB) + (size_t)s * NTOK * 128 + r * 8;
    LAS unsigned char* wl = lds + wave * 16384;
    LAS unsigned char* wrb = wl + (sub * 2) * 128 + ((c8 ^ (((sub & 1) << 1) | (((sub >> 2) & 1) << 2))) * 16);
    const int swr = (((r >> 1) & 1) << 1) | (((r >> 3) & 1) << 2);
    const LAS unsigned char* rd0 = wl + r * 128 + ((q ^ swr) * 16);
    const LAS unsigned char* rd1 = wl + r * 128 + (((4 + q) ^ swr) * 16);
    const int sc_b = 0x80 - 3 * (r & 3);
    u32x4 ev[4], raw[16];
    i32x4 bq0 = {0, 0, 0, 0}, bq1 = {0, 0, 0, 0};
#pragma unroll
    for (int j = 0; j < 4; ++j) ev[j] = *(const u32x4*)(ep0 + (size_t)tbase * 128 + j * 4);
    if (r < 4) { bq0 = *(const i32x4*)(hb + (size_t)tbase * (DM / 2)); bq1 = *(const i32x4*)(hb + (size_t)tbase * (DM / 2) + 64); }
#pragma unroll
    for (int g = 0; g < 16; ++g) raw[g] = *(const u32x4*)(EU + (size_t)ev[g >> 2][g & 3] * 128);
#pragma unroll
    for (int j = 0; j < 4; ++j) ev[j] = *(const u32x4*)(ep0 + (size_t)(tbase + 1) * 128 + j * 4);
    const i32x4 z4 = {0, 0, 0, 0};
#pragma unroll 1
    for (int i = 0; i < PEER_UNIT / 8; ++i) {
        const int tok = tbase + i;
        const int tn1 = tok + (i + 1 < PEER_UNIT / 8 ? 1 : 0), tn2 = tok + (i + 2 < PEER_UNIT / 8 ? 2 : 0);
#pragma unroll
        for (int g = 0; g < 16; ++g) *(LAS u32x4*)(wrb + (g & 7) * 2048 + (g >> 3) * 128) = raw[g];
        const i32x8 bf0 = __builtin_shufflevector(bq0, z4, 0, 1, 2, 3, 4, 5, 6, 7), bf1 = __builtin_shufflevector(bq1, z4, 0, 1, 2, 3, 4, 5, 6, 7);
        u32x4 ev2[4];
#pragma unroll
        for (int j = 0; j < 4; ++j) ev2[j] = *(const u32x4*)(ep0 + (size_t)tn2 * 128 + j * 4);
        i32x4 bn0 = {0, 0, 0, 0}, bn1 = {0, 0, 0, 0};
        if (r < 4) { bn0 = *(const i32x4*)(hb + (size_t)tn1 * (DM / 2)); bn1 = *(const i32x4*)(hb + (size_t)tn1 * (DM / 2) + 64); }
#pragma unroll
        for (int g = 0; g < 16; ++g) raw[g] = *(const u32x4*)(EU + (size_t)ev[g >> 2][g & 3] * 128);
        i32x4 af[8][2];
#pragma unroll
        for (int mt = 0; mt < 8; ++mt) { af[mt][0] = *(const LAS i32x4*)(rd0 + mt * 2048); af[mt][1] = *(const LAS i32x4*)(rd1 + mt * 2048); }
        float D[8];
#pragma unroll
        for (int mt = 0; mt < 8; ++mt) {
            const i32x8 af0 = __builtin_shufflevector(af[mt][0], z4, 0, 1, 2, 3, 4, 5, 6, 7), af1 = __builtin_shufflevector(af[mt][1], z4, 0, 1, 2, 3, 4, 5, 6, 7);
            f32x4 acc = __builtin_amdgcn_mfma_scale_f32_16x16x128_f8f6f4(bf0, af0, (f32x4){0.f, 0.f, 0.f, 0.f}, 4, 4, 0, sc_b, 0, 0x79);
            acc = __builtin_amdgcn_mfma_scale_f32_16x16x128_f8f6f4(bf1, af1, acc, 4, 4, 0, sc_b, 0, 0x79);
            asm volatile("" : "+v"(acc));
            D[mt] = (acc[0] + acc[1]) + (acc[2] + acc[3]);
        }
        if (q == 0) {
            *(f32x4*)(slab + (size_t)tok * 128) = (f32x4){D[0], D[1], D[2], D[3]};
            *(f32x4*)(slab + (size_t)tok * 128 + 4) = (f32x4){D[4], D[5], D[6], D[7]};
        }
#pragma unroll
        for (int j = 0; j < 4; ++j) ev[j] = ev2[j];
        bq0 = bn0; bq1 = bn1;
    }
}

typedef int i32x2 __attribute__((ext_vector_type(2)));
__device__ __forceinline__ void peer_v_unit_m(const Args& a, int s, int chunk, LAS unsigned char* lds) {
    unsigned char* ws = a.ws;
    int tid_ = threadIdx.x; asm volatile("" : "+v"(tid_));
    const int lane = tid_ & 63, wave = __builtin_amdgcn_readfirstlane(tid_ >> 6), sub = lane >> 3, c8 = lane & 7, r = lane & 15, q = lane >> 4;
    const unsigned char* EV = ws + WS_EV + (size_t)s * 16384 * 128 + c8 * 16;
    const int tbase = chunk * PEER_UNIT + wave * (PEER_UNIT / 8);
    const int* ep0 = (const int*)(ws + WS_PEI) + sub * 16;
    const unsigned char* cb = ws + WS_C4 + (size_t)(r & 3) * NTOK * 64 + q * 16;
    LAS unsigned char* wl = lds + wave * 16384;
    LAS unsigned char* wbase = wl + sub * 2048;
    const int c16 = c8 * 16;
    const LAS unsigned char* rdx[8];
#pragma unroll
    for (int c = 0; c < 8; ++c) rdx[c] = wl + (32 * q + r) * 128 + ((c ^ ((r >> 1) & 7)) * 16);
    const int sc_a = 0x7e - 3 * (r & 3);
    float* ob = a.out + s * 256 + r * 16 + q * 4;
    u32x4 ev[4], raw[16];
#pragma unroll
    for (int j = 0; j < 4; ++j) ev[j] = *(const u32x4*)(ep0 + (size_t)tbase * 128 + j * 4);
    i32x4 b0 = *(const i32x4*)(cb + (size_t)tbase * 64);
    f32x4 xo = *(const f32x4*)(ob + (size_t)tbase * DM);
#pragma unroll
    for (int g = 0; g < 16; ++g) raw[g] = *(const u32x4*)(EV + (size_t)ev[g >> 2][g & 3] * 128);
#pragma unroll
    for (int j = 0; j < 4; ++j) ev[j] = *(const u32x4*)(ep0 + (size_t)(tbase + 1) * 128 + j * 4);
    const i32x4 z4 = {0, 0, 0, 0};
#pragma unroll 1
    for (int i = 0; i < PEER_UNIT / 8; ++i) {
        const int tok = tbase + i;
        const int tn1 = tok + (i + 1 < PEER_UNIT / 8 ? 1 : 0), tn2 = tok + (i + 2 < PEER_UNIT / 8 ? 2 : 0);
#pragma unroll
        for (int g = 0; g < 16; ++g) *(LAS u32x4*)(wbase + g * 128 + (c16 ^ (((g >> 1) & 7) * 16))) = raw[g];
        const i32x8 wfrag = __builtin_shufflevector(b0, z4, 0, 1, 2, 3, 4, 5, 6, 7);
        u32x4 ev2[4];
#pragma unroll
        for (int j = 0; j < 4; ++j) ev2[j] = *(const u32x4*)(ep0 + (size_t)tn2 * 128 + j * 4);
        const i32x4 bn = *(const i32x4*)(cb + (size_t)tn1 * 64);
        const f32x4 xn = *(const f32x4*)(ob + (size_t)tn1 * DM);
#pragma unroll
        for (int g = 0; g < 16; ++g) raw[g] = *(const u32x4*)(EV + (size_t)ev[g >> 2][g & 3] * 128);
        f32x4 res;
#pragma unroll
        for (int k = 0; k < 4; ++k) {
            float d4[4];
#pragma unroll
            for (int c4 = 0; c4 < 4; ++c4) {
                const int ct = 4 * k + c4;
                const i32x2 t0 = __builtin_amdgcn_ds_read_tr4_b64_v2i32((LAS i32x2*)(rdx[ct >> 1] + (ct & 1) * 8));
                const i32x2 t1 = __builtin_amdgcn_ds_read_tr4_b64_v2i32((LAS i32x2*)(rdx[ct >> 1] + (ct & 1) * 8 + 2048));
                const i32x8 vfrag = {t0[0], t0[1], t1[0], t1[1], 0, 0, 0, 0};
                f32x4 acc = __builtin_amdgcn_mfma_scale_f32_16x16x128_f8f6f4(wfrag, vfrag, (f32x4){0.f, 0.f, 0.f, 0.f}, 4, 4, 0, sc_a, 0, 0x7f);
                asm volatile("" : "+v"(acc));
                d4[c4] = (acc[0] + acc[1]) + (acc[2] + acc[3]);
            }
            res[k] = q == 0 ? d4[0] : q == 1 ? d4[1] : q == 2 ? d4[2] : d4[3];
        }
        *(f32x4*)(ob + (size_t)tok * DM) = xo + res;
#pragma unroll
        for (int j = 0; j < 4; ++j) ev[j] = ev2[j];
        b0 = bn; xo = xn;
    }
}


__global__ void __launch_bounds__(512, 2) fwd(Args a) {
    extern __shared__ __attribute__((aligned(16))) unsigned char lds_raw[];
    LAS unsigned char* lds = (LAS unsigned char*)lds_raw;
    unsigned char* ws = a.ws;
    const int lo = a.ph_lo, hi = a.ph_hi;
    volatile LAS unsigned* misc = (volatile LAS unsigned*)(lds + MISC_OFF);
    if (threadIdx.x < 4) misc[threadIdx.x] = 0u;
    __syncthreads();
    XcdBarrier bar; bar.bar = (unsigned*)(ws + WS_CTL); bar.x = 0; bar.st = misc;
    if (a.use_bar) bar = xcd_barrier_post((unsigned*)(ws + WS_CTL), misc);
#define IN(k) (lo <= (k) && (k) < hi)
#define SEAM(k) do { if (a.use_bar && IN(k) && IN((k) + 1)) xcd_barrier(bar); } while (0)

    if (IN(0)) { p0_prep(a, lds); }
    SEAM(0);
    if (IN(1)) {
        pg8::Gemm g{(const bf16_t*)(ws + WS_A), (const bf16_t*)(ws + WS_WIN), NTOK, INP, DM};
        pg8::StaticOrder S; S.init(NTOK, INP, gridDim.x, blockIdx.x);
        EpiIn E{ws};
        pg8::gemm_phase<EpiIn, pg8::StaticOrder>(lds, g, S, E);
    }
    SEAM(1);
    unsigned* qctr = (unsigned*)(ws + WS_CTL + 16384);
    volatile LAS int* tslot = (volatile LAS int*)(lds + MISC_OFF + 64);
    if (IN(2)) {
        for (;;) {
            const int it = next_ticket(qctr, tslot);
            if (it >= 1408) break;
            if (it < 128) compress_item(a, it, lds);
            else if (it < 1152) { const int t2 = it - 128, bh = t2 & 63; sb_qblock4(a, bh >> 3, bh & 7, 15 - (t2 >> 6), lds); }
            else fixup_item(a, it - 1152);
        }
    }
    SEAM(2);
    if (IN(3)) {
        for (;;) {
            const int it = next_ticket(qctr + 64, tslot);
            if (it >= 1024) break;
            nsa_item2(a, ((it & 15) << 6) | (63 - (it >> 4)), lds);
        }
    }
    SEAM(3);
    if (IN(4)) { norm_mixed(a); }
    SEAM(4);
    if (IN(5)) {
        pg8::Gemm g{(const bf16_t*)(ws + WS_A), (const bf16_t*)(ws + WS_WOUT), NTOK, DM, DM};
        pg8::StaticOrder S; S.init(NTOK, DM, gridDim.x, blockIdx.x);
        EpiResF32 E{a.in[0], a.out};
        pg8::gemm_phase<EpiResF32, pg8::StaticOrder>(lds, g, S, E);
    }
    SEAM(5);
    if (IN(6)) { rms_rows(a.out, a.in[14], (bf16_t*)(ws + WS_A), ws + WS_H4, ws + WS_H4); }
    SEAM(6);
    if (IN(7)) {
        pg8::Gemm g{(const bf16_t*)(ws + WS_A), (const bf16_t*)(ws + WS_WQ), NTOK, DM, DM};
        pg8::StaticOrder S; S.init(NTOK, DM, gridDim.x, blockIdx.x);
        EpiBf16Row E{(bf16_t*)(ws + WS_QP), DM};
        pg8::gemm_phase<EpiBf16Row, pg8::StaticOrder>(lds, g, S, E);
    }
    SEAM(7);
    if (IN(8)) {
        const int lane = threadIdx.x & 63, wave = __builtin_amdgcn_readfirstlane(threadIdx.x >> 6);
        for (int tile = blockIdx.x; tile < NTOK / 64; tile += gridDim.x)
            for (int task = wave; task < 32; task += 8) peer_topk_task(a, tile, task & 3, task >> 2, lds, lane);
    }
    SEAM(8);
    const int home = (int)(xb_xcc_id() & 7u);
    if (IN(9)) {
        for (int j = 0; j < 8; ++j) {
            const int sl = (home + j) & 7;
            for (int t = next_ticket(qctr + 64 * (2 + sl), tslot); t < NTOK / PEER_UNIT;) { const unsigned nx = ticket_request(qctr + 64 * (2 + sl)); peer_u_unit_m(a, sl, t, lds); t = ticket_publish(nx, tslot); }
        }
    }
    SEAM(9);
    if (IN(10)) {
        const float* slab = (const float*)(ws + WS_SLAB); const float* pwg = (const float*)(ws + WS_PWG); float* pw = (float*)(ws + WS_PW);
        for (size_t i = ((size_t)blockIdx.x * 512 + threadIdx.x) * 4; i < (size_t)NTOK * 128; i += (size_t)gridDim.x * 512 * 4) {
            f32x4 d = *(const f32x4*)(slab + i);
#pragma unroll
            for (int sl = 1; sl < 8; ++sl) d += *(const f32x4*)(slab + (size_t)sl * NTOK * 128 + i);
            const f32x4 g4 = *(const f32x4*)(pwg + i);
            f32x4 o; o[0] = g4[0] * gelu_tanh(d[0]) * 0.35355339f; o[1] = g4[1] * gelu_tanh(d[1]) * 0.35355339f; o[2] = g4[2] * gelu_tanh(d[2]) * 0.35355339f; o[3] = g4[3] * gelu_tanh(d[3]) * 0.35355339f;
            *(f32x4*)(pw + i) = o;
            {
                float x0 = o[0] * 2.0f, x1 = o[1] * 2.0f, x2 = o[2] * 2.0f, x3 = o[3] * 2.0f;
#pragma unroll
                for (int t = 0; t < 4; ++t) {
                    unsigned p = 0u;
                    p = __builtin_amdgcn_cvt_scalef32_pk_fp4_f32(p, x0, x1, 1.0f, 0); p = __builtin_amdgcn_cvt_scalef32_pk_fp4_f32(p, x2, x3, 1.0f, 1);
                    *(unsigned short*)(ws + WS_C4 + (size_t)t * NTOK * 64 + (i >> 1)) = (unsigned short)p;
                    const f32x2 d01 = __builtin_amdgcn_cvt_scalef32_pk_f32_fp4(p, 1.0f, 0), d23 = __builtin_amdgcn_cvt_scalef32_pk_f32_fp4(p, 1.0f, 1);
                    x0 = (x0 - d01[0]) * 8.0f; x1 = (x1 - d01[1]) * 8.0f; x2 = (x2 - d23[0]) * 8.0f; x3 = (x3 - d23[1]) * 8.0f;
                }
            }
        }
    }
    SEAM(10);
    if (IN(11)) {
        for (int j = 0; j < 8; ++j) {
            const int sl = (home + j) & 7;
            for (int t = next_ticket(qctr + 64 * (18 + sl), tslot); t < NTOK / PEER_UNIT;) { const unsigned nx = ticket_request(qctr + 64 * (18 + sl)); peer_v_unit_m(a, sl, t, lds); t = ticket_publish(nx, tslot); }
        }
    }
#undef IN
#undef SEAM
}


extern "C" void kernel_launch(void* const* d_in, const int* in_sizes, int n_in, void* d_out, int out_size, void* d_ws, size_t ws_size, hipStream_t stream) {
    static int grid = 0;
    if (grid == 0) {
        if (n_in != 19 || out_size != NTOK * DM || ws_size < WS_END) { fprintf(stderr, "kernel_launch: unexpected shapes (n_in %d out %d ws %zu need %zu)\n", n_in, out_size, ws_size, (size_t)WS_END); grid = -1; return; }
        int dev = 0, cus = 0, per_cu = 0;
        if (hipGetDevice(&dev) != hipSuccess || hipDeviceGetAttribute(&cus, hipDeviceAttributeMultiprocessorCount, dev) != hipSuccess) { grid = -1; return; }
        if (hipFuncSetAttribute((const void*)fwd, hipFuncAttributeMaxDynamicSharedMemorySize, LDS_BYTES) != hipSuccess) { fprintf(stderr, "kernel_launch: hipFuncSetAttribute failed\n"); grid = -1; return; }
        if (hipOccupancyMaxActiveBlocksPerMultiprocessor(&per_cu, (const void*)fwd, 512, LDS_BYTES) != hipSuccess || per_cu < 1) { fprintf(stderr, "kernel_launch: occupancy query says %d\n", per_cu); (void)hipGetLastError(); grid = -1; return; }
        grid = cus;
    }
    if (grid < 0) return;
    (void)in_sizes;
    Args a{};
    for (int i = 0; i < 19; ++i) a.in[i] = (const float*)d_in[i];
    a.out = (float*)d_out; a.ws = (unsigned char*)d_ws; a.pad = 0;
#if N_LAUNCH_MODE == 1
    (void)hipMemsetAsync((char*)d_ws + WS_CTL, 0, CTL_BYTES, stream);
    a.ph_lo = 0; a.ph_hi = NPH; a.use_bar = 1;
    hipLaunchKernelGGL(fwd, dim3(grid), dim3(512), LDS_BYTES, stream, a);
#else
    (void)hipMemsetAsync((char*)d_ws + WS_CTL, 0, CTL_BYTES, stream);
    for (int p = 0; p < NPH; ++p) {
        a.ph_lo = p; a.ph_hi = p + 1; a.use_bar = 0;
        hipLaunchKernelGGL(fwd, dim3(grid), dim3(512), LDS_BYTES, stream, a);
    }
#endif
}
```

```cpp
#include <hip/hip_runtime.h>
#include <cstdio>
#include <cstdint>

#ifndef N_LAUNCH_MODE
#define N_LAUNCH_MODE 1
#endif

#define LAS __attribute__((address_space(3)))
typedef unsigned short bf16_t;
typedef short bf16x8 __attribute__((ext_vector_type(8)));
typedef float f32x4 __attribute__((ext_vector_type(4)));
typedef float f32x2 __attribute__((ext_vector_type(2)));
typedef unsigned u32x4 __attribute__((ext_vector_type(4)));
typedef unsigned u32x2 __attribute__((ext_vector_type(2)));

constexpr int NB = 8, NT = 4096, DM = 2048, NTOK = NB * NT;
constexpr int INC = 5656, INP = 5888;
constexpr float EPS = 1e-6f;
constexpr float LOG2E = 1.4426950408889634f;
constexpr float QSCALE = 0.08838834764831845f * 1.4426950408889634f;
constexpr int NPH = 12;
constexpr int NTERM = 3;

constexpr size_t WS_CTL = 0, CTL_BYTES = 65536;
constexpr size_t WS_WIN = WS_CTL + CTL_BYTES;
constexpr size_t WS_WOUT = WS_WIN + (size_t)INP * DM * 2;
constexpr size_t WS_WQ = WS_WOUT + (size_t)DM * DM * 2;
constexpr size_t WS_CW1 = WS_WQ + (size_t)DM * DM * 2;
constexpr size_t WS_CW2 = WS_CW1 + (size_t)2 * 256 * 4096 * 2;
constexpr size_t WS_CB = WS_CW2 + (size_t)2 * 128 * 256 * 2;
constexpr size_t WS_SUBK = WS_CB + 2 * 256 * 4;
constexpr size_t WS_EU = WS_SUBK + (size_t)8 * 2 * 128 * 128 * 2;
constexpr size_t WS_EV = WS_EU + (size_t)16384 * DM * 2;
constexpr size_t WS_A = WS_EV + (size_t)16384 * DM * 2;
constexpr size_t WS_ORAW = WS_A + (size_t)NTOK * DM * 2;
constexpr size_t WS_KC = WS_ORAW + (size_t)NTOK * DM * 2;
constexpr size_t WS_VCT = WS_KC + (size_t)16 * 256 * 128 * 2;
constexpr size_t SZ_BIG = (size_t)NTOK * 1024 * 2, SZ_SM = (size_t)NTOK * 256 * 2;
constexpr size_t WS_QSB = WS_VCT + (size_t)16 * 128 * 256 * 2;
constexpr size_t WS_KSB = WS_QSB + SZ_BIG;
constexpr size_t WS_VSBT = WS_KSB + SZ_BIG;
constexpr size_t WS_QN = WS_VSBT + SZ_BIG;
constexpr size_t WS_KCI = WS_QN + SZ_BIG;
constexpr size_t WS_VCI = WS_KCI + SZ_SM;
constexpr size_t WS_KSL = WS_VCI + SZ_SM;
constexpr size_t WS_VSLT = WS_KSL + SZ_SM;
constexpr size_t WS_KWI = WS_VSLT + SZ_SM;
constexpr size_t WS_VWIT = WS_KWI + SZ_SM;
constexpr size_t WS_GT = WS_VWIT + SZ_SM;
constexpr size_t WS_QN2 = WS_GT + (size_t)NTOK * 32 * 2;
constexpr size_t WS_KSL2 = WS_QN2 + SZ_BIG;
constexpr size_t WS_KWI2 = WS_KSL2 + SZ_SM;
constexpr size_t WS_H4 = WS_KWI2 + SZ_SM;
constexpr size_t WS_C4 = WS_H4 + (size_t)4 * NTOK * (DM / 2);
constexpr size_t WS_SS = WS_C4 + (size_t)4 * NTOK * 64;
constexpr size_t WS_END = WS_SS + (size_t)16 * NTOK * 4;
constexpr size_t WS_QP = WS_QSB;
constexpr size_t WS_PEI = WS_ORAW;
constexpr size_t WS_PWG = WS_ORAW + (size_t)NTOK * 128 * 4;
constexpr size_t WS_PW = WS_ORAW + (size_t)2 * NTOK * 128 * 4;
constexpr size_t WS_SLAB = WS_VSBT;
constexpr size_t WS_RS = WS_KC;
constexpr size_t WS_X1B = WS_KCI;
static_assert(WS_SLAB + (size_t)8 * NTOK * 128 * 2 <= WS_KCI && WS_X1B + (size_t)NTOK * DM * 2 <= WS_H4, "PEER scratch must fit in the dead attention buffers");

constexpr int LDS_BYTES = 147456;
constexpr int MISC_OFF = 131072;

struct Args { const float* in[19]; float* out; unsigned char* ws; int ph_lo, ph_hi, use_bar, pad; };

typedef __bf16 bf16x2v __attribute__((ext_vector_type(2)));
__device__ __forceinline__ unsigned cvt_pk_bf16(float lo, float hi) {
    const f32x2 v = {lo, hi}; union { bf16x2v b; unsigned u; } c; c.b = __builtin_convertvector(v, bf16x2v); return c.u;
}
__device__ __forceinline__ float bf_lo(unsigned u) { return __uint_as_float(u << 16); }
__device__ __forceinline__ float bf_hi(unsigned u) { return __uint_as_float(u & 0xffff0000u); }
__device__ __forceinline__ float fexp2(float x) { return __builtin_amdgcn_exp2f(x); }
__device__ __forceinline__ float frcp(float x) { return __builtin_amdgcn_rcpf(x); }
__device__ __forceinline__ float wave_sum(float v) {
#pragma unroll
    for (int o = 32; o > 0; o >>= 1) v += __shfl_xor(v, o);
    return v;
}
__device__ __forceinline__ float gelu_tanh(float x) {
    const float y = 0.7978845608028654f * (x + 0.044715f * x * x * x);
    const float e = fexp2(2.0f * LOG2E * y);
    return x * (1.0f - frcp(1.0f + e));
}

__device__ __forceinline__ unsigned row4_max_u32(unsigned m) {
    const u32x2 s = __builtin_amdgcn_permlane32_swap(m, m, false, false);
    const unsigned t = s.x > s.y ? s.x : s.y;
    const u32x2 u = __builtin_amdgcn_permlane16_swap(t, t, false, false);
    return u.x > u.y ? u.x : u.y;
}
__device__ __forceinline__ float row4_max_f32(float m) {
    const u32x2 s = __builtin_amdgcn_permlane32_swap(__float_as_uint(m), __float_as_uint(m), false, false);
    const float t = fmaxf(__uint_as_float(s.x), __uint_as_float(s.y));
    const u32x2 u = __builtin_amdgcn_permlane16_swap(__float_as_uint(t), __float_as_uint(t), false, false);
    return fmaxf(__uint_as_float(u.x), __uint_as_float(u.y));
}
__device__ __forceinline__ float row4_sum_f32(float m) {
    const u32x2 s = __builtin_amdgcn_permlane32_swap(__float_as_uint(m), __float_as_uint(m), false, false);
    const float t = __uint_as_float(s.x) + __uint_as_float(s.y);
    const u32x2 u = __builtin_amdgcn_permlane16_swap(__float_as_uint(t), __float_as_uint(t), false, false);
    return __uint_as_float(u.x) + __uint_as_float(u.y);
}
__device__ __forceinline__ unsigned f2sort(float v) { const unsigned b = __float_as_uint(v); return b ^ ((unsigned)((int)b >> 31) | 0x80000000u); }
__device__ __forceinline__ float sort2f(unsigned u) { return __uint_as_float((u >> 31) ? (u ^ 0x80000000u) : ~u); }

template <int N, int M>
__device__ __forceinline__ void bitonic_sort_desc(unsigned (&v)[M], int base) {
#pragma unroll
    for (int k = 2; k <= N; k <<= 1)
#pragma unroll
        for (int j = k >> 1; j > 0; j >>= 1)
#pragma unroll
            for (int i = 0; i < N; ++i) {
                const int l = i ^ j;
                if (l > i) {
                    const unsigned a = v[base + i], b = v[base + l];
                    const unsigned hi = a > b ? a : b, lo = a > b ? b : a;
                    const bool desc = (i & k) == 0;
                    v[base + i] = desc ? hi : lo; v[base + l] = desc ? lo : hi;
                }
            }
}
template <int N>
__device__ __forceinline__ void bitonic_merge_desc(unsigned (&v)[N]) {
#pragma unroll
    for (int j = N >> 1; j > 0; j >>= 1)
#pragma unroll
        for (int i = 0; i < N; ++i) {
            const int l = i ^ j;
            if (l > i) { const unsigned a = v[i], b = v[l]; v[i] = a > b ? a : b; v[l] = a > b ? b : a; }
        }
}
__device__ __forceinline__ unsigned partner32(unsigned x, int lane) { const u32x2 s = __builtin_amdgcn_permlane32_swap(x, x, false, false); return (lane & 32) ? s.x : s.y; }
__device__ __forceinline__ unsigned partner16(unsigned x, int lane) { const u32x2 s = __builtin_amdgcn_permlane16_swap(x, x, false, false); return (lane & 16) ? s.x : s.y; }
__device__ __forceinline__ bf16x8 as_bf16x8(u32x4 v) { union { u32x4 u; bf16x8 b; } c; c.u = v; return c.b; }
#define MFMA16(a, b, c) __builtin_amdgcn_mfma_f32_16x16x32_bf16((a), (b), (c), 0, 0, 0)

#define XB_TMO      128
#define XB_XCNT(j)  (256  + 64 * (j))
#define XB_XSUB(j)  (1280 + 64 * (j))
#define XB_XGEN(j)  (2304 + 64 * (j))
#define XB_TOP      3328
#define XB_TOPGEN   3392
#define XCD_BAR_WORDS 3456
#define XB_SPIN_CAP (1u << 20)
__device__ __forceinline__ unsigned xb_ld(unsigned* p)              { return __hip_atomic_load(p, __ATOMIC_RELAXED, __HIP_MEMORY_SCOPE_AGENT); }
__device__ __forceinline__ unsigned xb_add(unsigned* p, unsigned v) { return __hip_atomic_fetch_add(p, v, __ATOMIC_RELAXED, __HIP_MEMORY_SCOPE_AGENT); }
__device__ __forceinline__ unsigned xb_xcc_id() { return (unsigned)__builtin_amdgcn_s_getreg((3 << 11) | 20) & 0xFu; }
#define XB_SPIN(cond, bar) do { unsigned _sp = 0; while (cond) { __builtin_amdgcn_s_sleep(1); \
    if ((++_sp & 255u) == 0u) { if (xb_ld(&(bar)[XB_TMO])) break; if (_sp > XB_SPIN_CAP) { atomicAdd(&(bar)[XB_TMO], 1u); break; } } } } while (0)
struct XcdBarrier { unsigned* bar; unsigned x; volatile LAS unsigned* st; };
__device__ __forceinline__ XcdBarrier xcd_barrier_post(unsigned* bar, volatile LAS unsigned* st) {
    XcdBarrier b; b.bar = bar; b.x = xb_xcc_id(); b.st = st;
    if (threadIdx.x == 0) (void)xb_add(&bar[XB_XCNT(b.x)], 1u);
    return b;
}
__device__ __forceinline__ void xcd_barrier_complete(unsigned* bar, unsigned x, unsigned& nloc, unsigned& nx) {
    const unsigned G = gridDim.x * gridDim.y * gridDim.z;
    unsigned sum, cnt, mine, sp = 0u;
    for (;;) {
        sum = 0u; cnt = 0u; mine = 0u;
#pragma unroll
        for (unsigned j = 0; j < 16; ++j) { const unsigned c = xb_ld(&bar[XB_XCNT(j)]); sum += c; cnt += (c > 0u) ? 1u : 0u; mine = (j == x) ? c : mine; }
        if (sum == G) break;
        __builtin_amdgcn_s_sleep(1);
        if ((++sp & 255u) == 0u) { if (xb_ld(&bar[XB_TMO])) break; if (sp > XB_SPIN_CAP) { atomicAdd(&bar[XB_TMO], 1u); break; } }
    }
    nloc = mine > 0u ? mine : 1u; nx = cnt > 0u ? cnt : 1u;
}
__device__ __forceinline__ void xcd_barrier(const XcdBarrier& b) {
    asm volatile("s_waitcnt vmcnt(0)" ::: "memory");
    __syncthreads();
    if (threadIdx.x == 0) {
        unsigned* bar = b.bar;
        __builtin_amdgcn_s_waitcnt(0);
        unsigned nloc = b.st[0], nx = b.st[1];
        if (nloc == 0u) { xcd_barrier_complete(bar, b.x, nloc, nx); b.st[0] = nloc; b.st[1] = nx; }
        const unsigned old = xb_add(&bar[XB_XSUB(b.x)], 1u);
        const unsigned gen = old / nloc;
        if (old + 1u == (gen + 1u) * nloc) {
            __builtin_amdgcn_fence(__ATOMIC_RELEASE, "agent");
            asm volatile("s_waitcnt vmcnt(0)" ::: "memory");
            const unsigned og = xb_add(&bar[XB_TOP], 1u);
            const unsigned tg = og / nx;
            if (og + 1u == (tg + 1u) * nx) xb_add(&bar[XB_TOPGEN], 1u);
            else XB_SPIN(xb_ld(&bar[XB_TOPGEN]) == tg, bar);
            __builtin_amdgcn_fence(__ATOMIC_ACQUIRE, "agent");
            xb_add(&bar[XB_XGEN(b.x)], 1u);
            asm volatile("s_waitcnt vmcnt(0)" ::: "memory");
        } else {
            XB_SPIN(xb_ld(&bar[XB_XGEN(b.x)]) == gen, bar);
            __builtin_amdgcn_fence(__ATOMIC_ACQUIRE, "agent");
            asm volatile("s_waitcnt vmcnt(0)" ::: "memory");
        }
    }
    __syncthreads();
}

namespace pg8 {
constexpr int BM = 256, BK = 64, HALF = 128, HTB = HALF * BK * 2, STAGE_BYTES = 8 * HTB, NXCD = 8, WGM = 8;
__device__ __forceinline__ int lds_byte(int r, int c) { const int st = (r >> 4) * 2 + (c >> 5), rr = r & 15, cc = c & 31, ob = rr * 64 + cc * 2; return st * 1024 + (ob ^ (((ob >> 9) & 1) << 5)); }
__device__ __forceinline__ void stage_rc(int b, int& R, int& C) { const int st = b / 1024, sb = b % 1024, swz = sb ^ (((sb >> 9) & 1) << 5); R = (st >> 1) * 16 + swz / 64; C = (st & 1) * 32 + (swz % 64) / 2; }
__device__ __forceinline__ int perm32(int rho) { const int n = rho >> 4, i = rho & 15; return 8 * (i >> 2) + 4 * n + (i & 3); }
struct Unit { int pm, pn; };
struct Gemm { const bf16_t* A; const bf16_t* Bt; int M, N, K; };
struct StaticOrder {
    int nM, nN, nwg, G, c;
    __device__ void init(int M, int N, int G_, int c_) { nM = M / BM; nN = N / BM; nwg = nM * nN; G = G_; c = c_; }
    __device__ bool next(int i, Unit& u) const {
        const long L = (long)i * G + c; if (L >= nwg) return false;
        int wgid = (int)L; { const int q = nwg / NXCD, r = nwg % NXCD, xcd = wgid % NXCD, off = wgid / NXCD; wgid = (xcd < r ? xcd * (q + 1) : r * (q + 1) + (xcd - r) * q) + off; }
        const int nig = WGM * nN, gid = wgid / nig, fm = gid * WGM, gsz = (nM - fm) < WGM ? (nM - fm) : WGM;
        u.pm = fm + ((wgid % nig) % gsz); u.pn = (wgid % nig) / gsz; return true;
    }
    __device__ __forceinline__ void a_ready(const Unit&) const {}
    __device__ __forceinline__ void done(const Unit&) const {}
};

template <class Epi, class Sched>
__device__ __forceinline__ void gemm_phase(LAS unsigned char* lds, const Gemm g, const Sched& S, const Epi& E) {
    const int tid = threadIdx.x, wid = __builtin_amdgcn_readfirstlane(tid >> 6), lane = tid & 63, wr = wid >> 2, wc = wid & 3, fr = lane & 15, fq = lane >> 4;
    const int K = g.K, nt = K / BK;
    unsigned voffA[2], voffB[2];
#pragma unroll
    for (int i = 0; i < 2; ++i) { int R, C; stage_rc(tid * 16 + i * 8192, R, C); const int Rb = Epi::PERM ? ((R & ~31) + perm32(R & 31)) : R;
        voffA[i] = (unsigned)(R * K + C) * 2u; voffB[i] = (unsigned)(Rb * K + C) * 2u; }
    const size_t kstep = (size_t)(BK * 2);
    const size_t hstep = (size_t)HALF * K * 2;
    const size_t tstep = 2 * hstep;
    const unsigned ldsw = (unsigned)wid * 1024u;
    const int aoff = lds_byte(wr * 64 + fr, fq * 8), boff = lds_byte(wc * 32 + fr, fq * 8);
#define PG8_SA(b, h) (((b) * 2 + (h)) * HTB)
#define PG8_SB(b, h) ((4 + (b) * 2 + (h)) * HTB)
#define PG8_STAGE(bufoff, gbase, voff) do { _Pragma("unroll") for (int _i = 0; _i < 2; ++_i) \
        __builtin_amdgcn_global_load_lds((const unsigned*)((const char*)(gbase) + (voff)[_i]), (LAS unsigned*)(lds + (bufoff) + ldsw + _i * 8192), 16, 0, 0); } while (0)
#define PG8_LDA(dst, b, h) do { _Pragma("unroll") for (int m = 0; m < 4; ++m) _Pragma("unroll") for (int k = 0; k < 2; ++k) dst[m][k] = *(const LAS bf16x8*)(lds + PG8_SA(b, h) + aoff + m * 2048 + k * 1024); } while (0)
#define PG8_LDB(dst, b, h) do { _Pragma("unroll") for (int n = 0; n < 2; ++n) _Pragma("unroll") for (int k = 0; k < 2; ++k) dst[n][k] = *(const LAS bf16x8*)(lds + PG8_SB(b, h) + boff + n * 2048 + k * 1024); } while (0)
#define PG8_MMA(ai, bj, At, Bt) do { __builtin_amdgcn_s_setprio(1); _Pragma("unroll") for (int m = 0; m < 4; ++m) _Pragma("unroll") for (int n = 0; n < 2; ++n) _Pragma("unroll") for (int k = 0; k < 2; ++k) \
        acc[ai][bj][m][n] = __builtin_amdgcn_mfma_f32_16x16x32_bf16(Bt[n][k], At[m][k], acc[ai][bj][m][n], 0, 0, 0); __builtin_amdgcn_s_setprio(0); } while (0)
#define PG8_WAIT_V(n) asm volatile("s_waitcnt vmcnt(" #n ")" ::: "memory")
#define PG8_WAIT_L(n) asm volatile("s_waitcnt lgkmcnt(" #n ")" ::: "memory")
#define PG8_BAR __builtin_amdgcn_s_barrier()
#define PG8_SCHED __builtin_amdgcn_sched_barrier(0)
    Unit cur, nxt; int ui = 0;
    if (!S.next(0, cur)) return;
    f32x4 acc[2][2][4][2];
#pragma unroll
    for (int a = 0; a < 2; ++a)
#pragma unroll
        for (int b = 0; b < 2; ++b)
#pragma unroll
            for (int m = 0; m < 4; ++m)
#pragma unroll
                for (int n = 0; n < 2; ++n) acc[a][b][m][n] = (f32x4){0.f, 0.f, 0.f, 0.f};
    bf16x8 At[4][2], B0[2][2], B1[2][2];
    const char* cA = (const char*)g.A + (size_t)cur.pm * tstep; const char* cB = (const char*)g.Bt + (size_t)cur.pn * tstep;
    S.a_ready(cur);
    PG8_STAGE(PG8_SB(0, 0), cB, voffB); PG8_STAGE(PG8_SA(0, 0), cA, voffA); PG8_STAGE(PG8_SB(0, 1), cB + hstep, voffB); PG8_STAGE(PG8_SA(0, 1), cA + hstep, voffA);
    if (wr == 1) PG8_BAR;
    PG8_WAIT_V(4); PG8_BAR;
    PG8_STAGE(PG8_SB(1, 0), cB + kstep, voffB); PG8_STAGE(PG8_SA(1, 0), cA + kstep, voffA); PG8_STAGE(PG8_SB(1, 1), cB + hstep + kstep, voffB);
    PG8_WAIT_V(6); PG8_BAR;
    for (;;) {
        const bool has_next = S.next(ui + 1, nxt);
        const char* nA = has_next ? (const char*)g.A + (size_t)nxt.pm * tstep : cA; const char* nB = has_next ? (const char*)g.Bt + (size_t)nxt.pn * tstep : cB;
        for (int t = 0; t < nt; t += 2) {
            if constexpr (Epi::MIDSCALE) { if (t == nt / 2) E.mid(acc, cur, wr); }
            const bool last = (t == nt - 2);
            const char* a1 = cA + (size_t)(t + 1) * kstep;
            const char* a2 = last ? nA : cA + (size_t)(t + 2) * kstep; const char* b2 = last ? nB : cB + (size_t)(t + 2) * kstep;
            const char* a3 = a2 + kstep; const char* b3 = b2 + kstep;
            if (last && has_next) S.a_ready(nxt);
            PG8_LDB(B0, 0, 0); PG8_SCHED; PG8_LDA(At, 0, 0); PG8_STAGE(PG8_SA(1, 1), a1 + hstep, voffA);
            PG8_WAIT_L(8); PG8_BAR; PG8_WAIT_L(0); PG8_MMA(0, 0, At, B0); PG8_BAR; PG8_SCHED;
            PG8_LDB(B1, 0, 1); PG8_STAGE(PG8_SB(0, 0), b2, voffB);
            PG8_BAR; PG8_WAIT_L(0); PG8_MMA(0, 1, At, B1); PG8_BAR;
            PG8_LDA(At, 0, 1); PG8_STAGE(PG8_SA(0, 0), a2, voffA);
            PG8_BAR; PG8_WAIT_L(0); PG8_MMA(1, 0, At, B0); PG8_BAR; PG8_SCHED;
            PG8_STAGE(PG8_SB(0, 1), b2 + hstep, voffB);
            PG8_WAIT_V(6); PG8_BAR; PG8_MMA(1, 1, At, B1); PG8_BAR;
            PG8_LDB(B0, 1, 0); PG8_SCHED; PG8_LDA(At, 1, 0); PG8_STAGE(PG8_SA(0, 1), a2 + hstep, voffA);
            PG8_WAIT_L(8); PG8_BAR; PG8_WAIT_L(0); PG8_MMA(0, 0, At, B0); PG8_BAR; PG8_SCHED;
            PG8_LDB(B1, 1, 1); PG8_STAGE(PG8_SB(1, 0), b3, voffB);
            PG8_BAR; PG8_WAIT_L(0); PG8_MMA(0, 1, At, B1); PG8_BAR;
            PG8_LDA(At, 1, 1); PG8_STAGE(PG8_SA(1, 0), a3, voffA);
            PG8_BAR; PG8_WAIT_L(0); PG8_MMA(1, 0, At, B0); PG8_BAR; PG8_SCHED;
            PG8_STAGE(PG8_SB(1, 1), b3 + hstep, voffB);
            PG8_WAIT_V(6); PG8_BAR; PG8_MMA(1, 1, At, B1); PG8_BAR;
        }
        E(acc, cur, wr, wc, fr, fq); S.done(cur);
        if (!has_next) break;
#pragma unroll
        for (int a = 0; a < 2; ++a)
#pragma unroll
            for (int b = 0; b < 2; ++b)
#pragma unroll
                for (int m = 0; m < 4; ++m)
#pragma unroll
                    for (int n = 0; n < 2; ++n) acc[a][b][m][n] = (f32x4){0.f, 0.f, 0.f, 0.f};
        cur = nxt; cA = nA; cB = nB; ++ui;
    }
    PG8_WAIT_V(0);
    if (wr == 0) PG8_BAR;
    PG8_BAR;
#undef PG8_SA
#undef PG8_SB
#undef PG8_STAGE
#undef PG8_LDA
#undef PG8_LDB
#undef PG8_MMA
#undef PG8_WAIT_V
#undef PG8_WAIT_L
#undef PG8_BAR
#undef PG8_SCHED
}
}

struct EpiIn {
    static constexpr bool PERM = true, MIDSCALE = false;
    unsigned char* ws;
    __device__ __forceinline__ void operator()(const f32x4 (&acc)[2][2][4][2], const pg8::Unit& u, int wr, int wc, int fr, int fq) const {
#pragma unroll
        for (int bj = 0; bj < 2; ++bj) {
            const int gi = u.pn * 2 + bj;
            int mode; size_t off; int ld, hh = 0, nh = 1;
            if (gi < 8)       { mode = 0; off = WS_QSB + (size_t)gi * 256; ld = 1024; }
            else if (gi < 16) { mode = 4; off = WS_KSB; hh = gi - 8; nh = 8; ld = 0; }
            else if (gi < 24) { mode = 1; off = WS_VSBT; hh = gi - 16; nh = 8; ld = 0; }
            else if (gi < 32) { mode = 0; off = WS_QN + (size_t)(gi - 24) * 256; ld = 1024; }
            else if (gi < 34) { mode = 0; off = WS_KCI + (size_t)(gi - 32) * 256; ld = 256; }
            else if (gi < 36) { mode = 0; off = WS_VCI + (size_t)(gi - 34) * 256; ld = 256; }
            else if (gi < 38) { mode = 0; off = WS_KSL + (size_t)(gi - 36) * 256; ld = 256; }
            else if (gi < 40) { mode = 1; off = WS_VSLT; hh = gi - 38; nh = 2; ld = 0; }
            else if (gi < 42) { mode = 0; off = WS_KWI + (size_t)(gi - 40) * 256; ld = 256; }
            else if (gi < 44) { mode = 1; off = WS_VWIT; hh = gi - 42; nh = 2; ld = 0; }
            else if (gi == 44) { mode = 2; off = WS_GT; ld = 32; }
            else { mode = 3; off = 0; ld = 0; }
            if (mode == 3) continue;
            const int cin = wc * 32 + 8 * fq;
            bf16_t* base = (bf16_t*)(ws + off);
#pragma unroll
            for (int ai = 0; ai < 2; ++ai)
#pragma unroll
                for (int m = 0; m < 4; ++m) {
                    const int row = u.pm * 256 + ai * 128 + wr * 64 + m * 16 + fr;
                    const f32x4 v0 = acc[ai][bj][m][0], v1 = acc[ai][bj][m][1];
                    u32x4 w; w.x = cvt_pk_bf16(v0[0], v0[1]); w.y = cvt_pk_bf16(v0[2], v0[3]); w.z = cvt_pk_bf16(v1[0], v1[1]); w.w = cvt_pk_bf16(v1[2], v1[3]);
                    if (mode == 0) { *(u32x4*)(base + (size_t)row * ld + cin) = w; }
                    else if (mode == 4) { *(u32x4*)(base + ((size_t)((row >> 12) * nh + hh) * NT + (row & 4095)) * 128 + cin) = w; }
                    else if (mode == 2) { if (cin < 32) *(u32x4*)(base + (size_t)row * 32 + cin) = w; }
                    else {
                        const int b = row >> 12, t = row & 4095;
                        bf16_t* p = base + (((size_t)(b * nh + hh) * 64 + (t >> 6)) * 128 + cin) * 64 + (t & 63);
                        p[0 * 64] = (bf16_t)(w.x & 0xffffu); p[1 * 64] = (bf16_t)(w.x >> 16);
                        p[2 * 64] = (bf16_t)(w.y & 0xffffu); p[3 * 64] = (bf16_t)(w.y >> 16);
                        p[4 * 64] = (bf16_t)(w.z & 0xffffu); p[5 * 64] = (bf16_t)(w.z >> 16);
                        p[6 * 64] = (bf16_t)(w.w & 0xffffu); p[7 * 64] = (bf16_t)(w.w >> 16);
                    }
                }
        }
    }
};
struct EpiResBf16 {
    static constexpr bool PERM = true, MIDSCALE = true;
    const float* res; bf16_t* O; const float* rs;
    __device__ __forceinline__ void mid(f32x4 (&acc)[2][2][4][2], const pg8::Unit& u, int wr) const {
        asm volatile("s_nop 15\n\ts_nop 15\n\ts_nop 15" ::: "memory");
        int ln = (int)__builtin_amdgcn_mbcnt_hi(~0u, __builtin_amdgcn_mbcnt_lo(~0u, 0u)); asm volatile("" : "+v"(ln));
        const int row0 = u.pm * 256 + wr * 64 + (ln & 15);
#pragma unroll
        for (int ai = 0; ai < 2; ++ai)
#pragma unroll
            for (int m = 0; m < 4; ++m) {
                const f32x2 rv = *(const f32x2*)(rs + (size_t)(row0 + ai * 128 + m * 16) * 2);
                const float f = rv[0] * frcp(rv[1]);
#pragma unroll
                for (int bj = 0; bj < 2; ++bj)
#pragma unroll
                    for (int n = 0; n < 2; ++n) { acc[ai][bj][m][n][0] *= f; acc[ai][bj][m][n][1] *= f; acc[ai][bj][m][n][2] *= f; acc[ai][bj][m][n][3] *= f; }
            }
    }
    __device__ __forceinline__ void operator()(const f32x4 (&acc)[2][2][4][2], const pg8::Unit& u, int wr, int wc, int fr, int fq) const {
        const int row0 = u.pm * 256 + wr * 64 + fr, col0 = u.pn * 256 + wc * 32 + 8 * fq;
#pragma unroll
        for (int am = 0; am < 4; ++am) {
            const int ai = am >> 1, mb = (am & 1) * 2;
            f32x4 rr[2][2][2]; float r1[2];
#pragma unroll
            for (int mm = 0; mm < 2; ++mm) {
                r1[mm] = rs[(size_t)(row0 + ai * 128 + (mb + mm) * 16) * 2 + 1];
#pragma unroll
                for (int bj = 0; bj < 2; ++bj) {
                    const size_t ro = (size_t)(row0 + ai * 128 + (mb + mm) * 16) * DM + col0 + bj * 128;
                    rr[mm][bj][0] = *(const f32x4*)(res + ro); rr[mm][bj][1] = *(const f32x4*)(res + ro + 4);
                }
            }
#pragma unroll
            for (int mm = 0; mm < 2; ++mm)
#pragma unroll
                for (int bj = 0; bj < 2; ++bj) {
                    const int m = mb + mm;
                    const size_t ro = (size_t)(row0 + ai * 128 + m * 16) * DM + col0 + bj * 128;
                    const f32x4 v0 = acc[ai][bj][m][0] * r1[mm] + rr[mm][bj][0], v1 = acc[ai][bj][m][1] * r1[mm] + rr[mm][bj][1];
                    u32x4 w; w.x = cvt_pk_bf16(v0[0], v0[1]); w.y = cvt_pk_bf16(v0[2], v0[3]); w.z = cvt_pk_bf16(v1[0], v1[1]); w.w = cvt_pk_bf16(v1[2], v1[3]);
                    *(u32x4*)(O + ro) = w;
                }
        }
    }
};
struct EpiBf16Row {
    static constexpr bool PERM = true, MIDSCALE = false;
    bf16_t* O; int ld;
    __device__ __forceinline__ void operator()(const f32x4 (&acc)[2][2][4][2], const pg8::Unit& u, int wr, int wc, int fr, int fq) const {
        const int row0 = u.pm * 256 + wr * 64 + fr, col0 = u.pn * 256 + wc * 32 + 8 * fq;
#pragma unroll
        for (int ai = 0; ai < 2; ++ai)
#pragma unroll
            for (int m = 0; m < 4; ++m) {
                bf16_t* rowp = O + (size_t)(row0 + ai * 128 + m * 16) * ld + col0;
#pragma unroll
                for (int bj = 0; bj < 2; ++bj) {
                    const f32x4 v0 = acc[ai][bj][m][0], v1 = acc[ai][bj][m][1];
                    u32x4 w; w.x = cvt_pk_bf16(v0[0], v0[1]); w.y = cvt_pk_bf16(v0[2], v0[3]); w.z = cvt_pk_bf16(v1[0], v1[1]); w.w = cvt_pk_bf16(v1[2], v1[3]);
                    *(u32x4*)(rowp + bj * 128) = w;
                }
            }
    }
};
struct EpiBf16RowScale {
    static constexpr bool PERM = true, MIDSCALE = false;
    bf16_t* O; int ld; const float* rs;
    __device__ __forceinline__ void operator()(const f32x4 (&acc)[2][2][4][2], const pg8::Unit& u, int wr, int wc, int fr, int fq) const {
        const int row0 = u.pm * 256 + wr * 64 + fr, col0 = u.pn * 256 + wc * 32 + 8 * fq;
#pragma unroll
        for (int ai = 0; ai < 2; ++ai)
#pragma unroll
            for (int m = 0; m < 4; ++m) {
                bf16_t* rowp = O + (size_t)(row0 + ai * 128 + m * 16) * ld + col0;
                const float rsc = rs[(size_t)(row0 + ai * 128 + m * 16) * 2];
#pragma unroll
                for (int bj = 0; bj < 2; ++bj) {
                    const f32x4 v0 = acc[ai][bj][m][0] * rsc, v1 = acc[ai][bj][m][1] * rsc;
                    u32x4 w; w.x = cvt_pk_bf16(v0[0], v0[1]); w.y = cvt_pk_bf16(v0[2], v0[3]); w.z = cvt_pk_bf16(v1[0], v1[1]); w.w = cvt_pk_bf16(v1[2], v1[3]);
                    *(u32x4*)(rowp + bj * 128) = w;
                }
            }
    }
};

__device__ __forceinline__ void transpose_cvt(const float* __restrict__ src, int K, int N, bf16_t* __restrict__ dst, int Npad, LAS float* tile, const float* kg0 = nullptr, const float* kg1 = nullptr) {
    const int tid = threadIdx.x, ntn = Npad / 64, ntk = K / 64;
    for (int ti = blockIdx.x; ti < ntn * ntk; ti += gridDim.x) {
        const int n0 = (ti % ntn) * 64, k0 = (ti / ntn) * 64;
#pragma unroll
        for (int i = 0; i < 2; ++i) {
            const int kk = (tid >> 4) + i * 32, nn = (tid & 15) * 4;
            f32x4 v = (f32x4){0.f, 0.f, 0.f, 0.f};
            if (n0 + nn < N) v = *(const f32x4*)(src + (size_t)(k0 + kk) * N + n0 + nn);
            if (kg0) { const int k = k0 + kk; const float gk = k < 1024 ? kg0[k] : kg1[k - 1024]; v[0] *= gk; v[1] *= gk; v[2] *= gk; v[3] *= gk; }
            tile[kk * 65 + nn + 0] = v[0]; tile[kk * 65 + nn + 1] = v[1]; tile[kk * 65 + nn + 2] = v[2]; tile[kk * 65 + nn + 3] = v[3];
        }
        __syncthreads();
        {
            const int nn = tid >> 3, k8 = (tid & 7) * 8;
            float f[8];
#pragma unroll
            for (int j = 0; j < 8; ++j) f[j] = tile[(k8 + j) * 65 + nn];
            u32x4 w; w.x = cvt_pk_bf16(f[0], f[1]); w.y = cvt_pk_bf16(f[2], f[3]); w.z = cvt_pk_bf16(f[4], f[5]); w.w = cvt_pk_bf16(f[6], f[7]);
            *(u32x4*)(dst + (size_t)(n0 + nn) * K + k0 + k8) = w;
        }
        __syncthreads();
    }
}
__device__ __forceinline__ void cvt_copy(const float* __restrict__ src, bf16_t* __restrict__ dst, size_t n) {
    const size_t stride = (size_t)gridDim.x * 512 * 8;
    for (size_t i = ((size_t)blockIdx.x * 512 + threadIdx.x) * 8; i < n; i += stride) {
        const f32x4 a = *(const f32x4*)(src + i), b = *(const f32x4*)(src + i + 4);
        u32x4 w; w.x = cvt_pk_bf16(a[0], a[1]); w.y = cvt_pk_bf16(a[2], a[3]); w.z = cvt_pk_bf16(b[0], b[1]); w.w = cvt_pk_bf16(b[2], b[3]);
        *(u32x4*)(dst + i) = w;
    }
}
__device__ __forceinline__ void cvt_fp4(const float* __restrict__ src, unsigned char* __restrict__ dst, size_t n, float scale) {
    const size_t stride = (size_t)gridDim.x * 512 * 32;
    for (size_t i = ((size_t)blockIdx.x * 512 + threadIdx.x) * 32; i < n; i += stride) {
        u32x4 w;
#pragma unroll
        for (int j = 0; j < 4; ++j) {
            const f32x4 a0 = *(const f32x4*)(src + i + j * 8), a1 = *(const f32x4*)(src + i + j * 8 + 4);
            unsigned p = 0u;
            p = __builtin_amdgcn_cvt_scalef32_pk_fp4_f32(p, a0[0] * scale, a0[1] * scale, 1.0f, 0); p = __builtin_amdgcn_cvt_scalef32_pk_fp4_f32(p, a0[2] * scale, a0[3] * scale, 1.0f, 1);
            p = __builtin_amdgcn_cvt_scalef32_pk_fp4_f32(p, a1[0] * scale, a1[1] * scale, 1.0f, 2); p = __builtin_amdgcn_cvt_scalef32_pk_fp4_f32(p, a1[2] * scale, a1[3] * scale, 1.0f, 3);
            w[j] = p;
        }
        const size_t e = i >> 11, d = i & 2047;
        *(u32x4*)(dst + (((d >> 8) * 16384 + e) << 7) + ((d & 255) >> 1)) = w;
    }
}
__device__ __forceinline__ void cvt_fp4_vperm(const float* __restrict__ src, unsigned char* __restrict__ dst, float scale) {
    const int lane = threadIdx.x & 63, c = lane >> 2, q = lane & 3;
    for (int it = blockIdx.x * 8 + (threadIdx.x >> 6); it < 16384 * 8; it += gridDim.x * 8) {
        const int e = it >> 3, sl = it & 7;
        const f32x4 v = *(const f32x4*)(src + (size_t)e * DM + sl * 256 + lane * 4);
        unsigned p = 0u;
        p = __builtin_amdgcn_cvt_scalef32_pk_fp4_f32(p, v[0] * scale, v[1] * scale, 1.0f, 0); p = __builtin_amdgcn_cvt_scalef32_pk_fp4_f32(p, v[2] * scale, v[3] * scale, 1.0f, 1);
        const unsigned pn = (unsigned)__shfl_down((int)p, 4);
        if ((c & 1) == 0) {
            unsigned char* o = dst + ((((size_t)sl * 16384 + e) << 7)) + q * 8 + (c >> 1);
#pragma unroll
            for (int k = 0; k < 4; ++k) o[k * 32] = (unsigned char)(((p >> (4 * k)) & 15u) | (((pn >> (4 * k)) & 15u) << 4));
        }
    }
}
template <bool SRC_BF16 = false>
__device__ __forceinline__ void rms_rows(const void* __restrict__ srcv, const float* __restrict__ gain, bf16_t* __restrict__ dst, unsigned char* __restrict__ hi8 = nullptr, unsigned char* __restrict__ lo8 = nullptr) {
    const int lane = threadIdx.x & 63, wave = threadIdx.x >> 6;
    f32x4 g[8];
#pragma unroll
    for (int i = 0; i < 8; ++i) g[i] = *(const f32x4*)(gain + i * 256 + lane * 4);
    for (int row = blockIdx.x * 8 + wave; row < NTOK; row += gridDim.x * 8) {
        f32x4 v[8]; float ss = 0.f;
#pragma unroll
        for (int i = 0; i < 8; ++i) {
            if (SRC_BF16) { const u32x2 w = *(const u32x2*)((const bf16_t*)srcv + (size_t)row * DM + lane * 4 + i * 256); v[i] = (f32x4){bf_lo(w.x), bf_hi(w.x), bf_lo(w.y), bf_hi(w.y)}; }
            else v[i] = *(const f32x4*)((const float*)srcv + (size_t)row * DM + lane * 4 + i * 256);
            ss += v[i][0] * v[i][0] + v[i][1] * v[i][1] + v[i][2] * v[i][2] + v[i][3] * v[i][3];
        }
        ss = wave_sum(ss);
        const float rstd = rsqrtf(ss * (1.0f / DM) + EPS);
        bf16_t* o = dst + (size_t)row * DM + lane * 4;
#pragma unroll
        for (int i = 0; i < 8; ++i) {
            u32x2 w; w.x = cvt_pk_bf16(v[i][0] * rstd * g[i][0], v[i][1] * rstd * g[i][1]); w.y = cvt_pk_bf16(v[i][2] * rstd * g[i][2], v[i][3] * rstd * g[i][3]);
            *(u32x2*)(o + i * 256) = w;
            if (hi8) {
                float x0 = bf_lo(w.x) * 0.5f, x1 = bf_hi(w.x) * 0.5f, x2 = bf_lo(w.y) * 0.5f, x3 = bf_hi(w.y) * 0.5f;
#pragma unroll
                for (int t = 0; t < NTERM; ++t) {
                    unsigned p = 0u;
                    p = __builtin_amdgcn_cvt_scalef32_pk_fp4_f32(p, x0, x1, 1.0f, 0); p = __builtin_amdgcn_cvt_scalef32_pk_fp4_f32(p, x2, x3, 1.0f, 1);
                    *(unsigned short*)(hi8 + (size_t)t * NTOK * (DM / 2) + (size_t)row * (DM / 2) + i * 128 + lane * 2) = (unsigned short)p;
                    const f32x2 d01 = __builtin_amdgcn_cvt_scalef32_pk_f32_fp4(p, 1.0f, 0), d23 = __builtin_amdgcn_cvt_scalef32_pk_f32_fp4(p, 1.0f, 1);
                    x0 = (x0 - d01[0]) * 8.0f; x1 = (x1 - d01[1]) * 8.0f; x2 = (x2 - d23[0]) * 8.0f; x3 = (x3 - d23[1]) * 8.0f;
                }
            }
        }
    }
}
__device__ __forceinline__ void rms_terms(const bf16_t* __restrict__ src, const float* __restrict__ gain, unsigned char* __restrict__ h4, float* __restrict__ rs2) {
    const int lane = threadIdx.x & 63, wave = threadIdx.x >> 6;
    f32x4 g[8];
#pragma unroll
    for (int i = 0; i < 8; ++i) g[i] = *(const f32x4*)(gain + i * 256 + lane * 4);
    for (int rb = blockIdx.x * 8 + wave; rb < NTOK / 16; rb += gridDim.x * 8) {
        float mine = 0.f;
#pragma unroll 1
        for (int k = 0; k < 16; ++k) {
            const int row = rb * 16 + k;
            f32x4 v[8]; float ss = 0.f;
#pragma unroll
            for (int i = 0; i < 8; ++i) {
                const u32x2 w = *(const u32x2*)(src + (size_t)row * DM + lane * 4 + i * 256); v[i] = (f32x4){bf_lo(w.x), bf_hi(w.x), bf_lo(w.y), bf_hi(w.y)};
                ss += v[i][0] * v[i][0] + v[i][1] * v[i][1] + v[i][2] * v[i][2] + v[i][3] * v[i][3];
            }
            ss = wave_sum(ss);
            const float rstd = rsqrtf(ss * (1.0f / DM) + EPS);
            if (lane == k) mine = rstd;
#pragma unroll
            for (int i = 0; i < 8; ++i) {
                u32x2 w; w.x = cvt_pk_bf16(v[i][0] * rstd * g[i][0], v[i][1] * rstd * g[i][1]); w.y = cvt_pk_bf16(v[i][2] * rstd * g[i][2], v[i][3] * rstd * g[i][3]);
                float x0 = bf_lo(w.x) * 0.5f, x1 = bf_hi(w.x) * 0.5f, x2 = bf_lo(w.y) * 0.5f, x3 = bf_hi(w.y) * 0.5f;
#pragma unroll
                for (int t = 0; t < NTERM; ++t) {
                    unsigned p = 0u;
                    p = __builtin_amdgcn_cvt_scalef32_pk_fp4_f32(p, x0, x1, 1.0f, 0); p = __builtin_amdgcn_cvt_scalef32_pk_fp4_f32(p, x2, x3, 1.0f, 1);
                    *(unsigned short*)(h4 + (size_t)t * NTOK * (DM / 2) + (size_t)row * (DM / 2) + i * 128 + lane * 2) = (unsigned short)p;
                    const f32x2 d01 = __builtin_amdgcn_cvt_scalef32_pk_f32_fp4(p, 1.0f, 0), d23 = __builtin_amdgcn_cvt_scalef32_pk_f32_fp4(p, 1.0f, 1);
                    x0 = (x0 - d01[0]) * 8.0f; x1 = (x1 - d01[1]) * 8.0f; x2 = (x2 - d23[0]) * 8.0f; x3 = (x3 - d23[1]) * 8.0f;
                }
            }
        }
        if (lane < 16) *(f32x2*)(rs2 + (size_t)(rb * 16 + lane) * 2) = (f32x2){mine, 0.f};
    }
}
__device__ __forceinline__ void p0_prep(const Args& a, LAS unsigned char* lds) {
    unsigned char* ws = a.ws;
    LAS float* tile = (LAS float*)lds;
    transpose_cvt(a.in[2], DM, INC, (bf16_t*)(ws + WS_WIN), INP, tile);
    transpose_cvt(a.in[13], DM, DM, (bf16_t*)(ws + WS_WOUT), DM, tile, a.in[11], a.in[12]);
    transpose_cvt(a.in[15], DM, DM, (bf16_t*)(ws + WS_WQ), DM, tile, a.in[14], a.in[14] + 1024);
    transpose_cvt(a.in[4], 4096, 256, (bf16_t*)(ws + WS_CW1), 256, tile);
    transpose_cvt(a.in[6], 4096, 256, (bf16_t*)(ws + WS_CW1) + (size_t)256 * 4096, 256, tile);
    transpose_cvt(a.in[5], 256, 128, (bf16_t*)(ws + WS_CW2), 128, tile);
    transpose_cvt(a.in[7], 256, 128, (bf16_t*)(ws + WS_CW2) + (size_t)128 * 256, 128, tile);
    cvt_copy(a.in[16], (bf16_t*)(ws + WS_SUBK), (size_t)8 * 2 * 128 * 128);
    cvt_fp4(a.in[17], ws + WS_EU, (size_t)16384 * DM, 64.0f);
    cvt_fp4_vperm(a.in[18], ws + WS_EV, 2.8284271f);
    rms_rows(a.in[0], a.in[1], (bf16_t*)(ws + WS_A));
    __syncthreads();
    for (int o = blockIdx.x; o < 512; o += gridDim.x) {
        const int kv = o >> 8, n = o & 255; const float* w1 = a.in[kv ? 6 : 4]; const float* pe = a.in[3];
        float s = 0.f;
        for (int k = threadIdx.x; k < 4096; k += 512) s += pe[k] * w1[(size_t)k * 256 + n];
        s = wave_sum(s);
        if ((threadIdx.x & 63) == 0) tile[threadIdx.x >> 6] = s;
        __syncthreads();
        if (threadIdx.x == 0) { float t = 0.f; for (int i = 0; i < 8; ++i) t += tile[i]; __hip_atomic_store((float*)(ws + WS_CB) + o, t, __ATOMIC_RELAXED, __HIP_MEMORY_SCOPE_AGENT); }
        __syncthreads();
    }
}

constexpr int KROW = 272, VROW = 144, KBUF = 64 * KROW, VBUF = 128 * VROW, ABUF = KBUF + VBUF;
struct Stage { u32x4 k[2], v[2]; };
__device__ __forceinline__ void stage_load(Stage& s, const bf16_t* kblk, size_t ldk, const bf16_t* vblk, size_t ldv, int tid) {
#pragma unroll
    for (int i = 0; i < 2; ++i) {
        const int id = tid + i * 512;
        s.k[i] = *(const u32x4*)(kblk + (size_t)(id >> 4) * ldk + (id & 15) * 8);
        s.v[i] = *(const u32x4*)(vblk + (size_t)(id >> 3) * ldv + (id & 7) * 8);
    }
}
__device__ __forceinline__ void stage_load_k(Stage& s, const bf16_t* kblk, size_t ldk, int tid) {
#pragma unroll
    for (int i = 0; i < 2; ++i) { const int id = tid + i * 512; s.k[i] = *(const u32x4*)(kblk + (size_t)(id >> 4) * ldk + (id & 15) * 8); }
}
__device__ __forceinline__ void stage_store(const Stage& s, LAS unsigned char* buf, int tid, bool withv) {
#pragma unroll
    for (int i = 0; i < 2; ++i) {
        const int id = tid + i * 512; const int kx = id >> 4;
        const int rho = ((kx >> 2) & 3) * 16 + (kx >> 4) * 4 + (kx & 3);
        *(LAS u32x4*)(buf + rho * KROW + (id & 15) * 16) = s.k[i];
        if (withv) *(LAS u32x4*)(buf + KBUF + (id >> 3) * VROW + (id & 7) * 16) = s.v[i];
    }
}
__device__ __forceinline__ void load_q(const bf16_t* qp, float scale, bf16x8 (&Bq)[4], int q) {
#pragma unroll
    for (int kk = 0; kk < 4; ++kk) {
        const u32x4 raw = *(const u32x4*)(qp + kk * 32 + q * 8);
        u32x4 w;
        w.x = cvt_pk_bf16(bf_lo(raw.x) * scale, bf_hi(raw.x) * scale); w.y = cvt_pk_bf16(bf_lo(raw.y) * scale, bf_hi(raw.y) * scale);
        w.z = cvt_pk_bf16(bf_lo(raw.z) * scale, bf_hi(raw.z) * scale); w.w = cvt_pk_bf16(bf_lo(raw.w) * scale, bf_hi(raw.w) * scale);
        Bq[kk] = as_bf16x8(w);
    }
}


__device__ __forceinline__ void load_q_norm(const bf16_t* qp, const float* gq, bf16x8 (&Bq)[4], int q) {
    u32x4 raw[4]; float ss = 0.f;
#pragma unroll
    for (int kk = 0; kk < 4; ++kk) {
        raw[kk] = *(const u32x4*)(qp + kk * 32 + q * 8);
        ss += bf_lo(raw[kk].x) * bf_lo(raw[kk].x) + bf_hi(raw[kk].x) * bf_hi(raw[kk].x) + bf_lo(raw[kk].y) * bf_lo(raw[kk].y) + bf_hi(raw[kk].y) * bf_hi(raw[kk].y)
            + bf_lo(raw[kk].z) * bf_lo(raw[kk].z) + bf_hi(raw[kk].z) * bf_hi(raw[kk].z) + bf_lo(raw[kk].w) * bf_lo(raw[kk].w) + bf_hi(raw[kk].w) * bf_hi(raw[kk].w);
    }
    ss = row4_sum_f32(ss);
    const float rstd = rsqrtf(ss * (1.0f / 128.0f) + EPS) * QSCALE;
#pragma unroll
    for (int kk = 0; kk < 4; ++kk) {
        const f32x4 g0 = *(const f32x4*)(gq + kk * 32 + q * 8), g1 = *(const f32x4*)(gq + kk * 32 + q * 8 + 4);
        u32x4 w;
        w.x = cvt_pk_bf16(bf_lo(raw[kk].x) * rstd * g0[0], bf_hi(raw[kk].x) * rstd * g0[1]); w.y = cvt_pk_bf16(bf_lo(raw[kk].y) * rstd * g0[2], bf_hi(raw[kk].y) * rstd * g0[3]);
        w.z = cvt_pk_bf16(bf_lo(raw[kk].z) * rstd * g1[0], bf_hi(raw[kk].z) * rstd * g1[1]); w.w = cvt_pk_bf16(bf_lo(raw[kk].w) * rstd * g1[2], bf_hi(raw[kk].w) * rstd * g1[3]);
        Bq[kk] = as_bf16x8(w);
    }
}
__device__ __forceinline__ void qk_block2(const LAS unsigned char* Kl, const bf16x8 (&Bq)[2][4], f32x4 (&S)[2][4], int r, int q) {
    const LAS unsigned char* kp = Kl + r * KROW + q * 16;
    bf16x8 A[2][4];
#pragma unroll
    for (int kk = 0; kk < 4; ++kk) A[0][kk] = *(const LAS bf16x8*)(kp + kk * 64);
#pragma unroll
    for (int n = 0; n < 4; ++n) {
        if (n < 3) {
#pragma unroll
            for (int kk = 0; kk < 4; ++kk) A[(n + 1) & 1][kk] = *(const LAS bf16x8*)(kp + (n + 1) * 16 * KROW + kk * 64);
        }
        S[0][n] = (f32x4){0.f, 0.f, 0.f, 0.f}; S[1][n] = (f32x4){0.f, 0.f, 0.f, 0.f};
#pragma unroll
        for (int kk = 0; kk < 4; ++kk) { S[0][n] = MFMA16(A[n & 1][kk], Bq[0][kk], S[0][n]); S[1][n] = MFMA16(A[n & 1][kk], Bq[1][kk], S[1][n]); }
    }
}
__device__ __forceinline__ void pv_block2(const LAS unsigned char* Vl, const bf16x8 (&P)[2][2], f32x4 (&O)[2][8], int r, int q) {
    const LAS unsigned char* vp = Vl + r * VROW + q * 32;
    bf16x8 A[2][4];
#pragma unroll
    for (int i = 0; i < 4; ++i) A[0][i] = *(const LAS bf16x8*)(vp + (i >> 1) * 16 * VROW + (i & 1) * 16);
#pragma unroll
    for (int gi = 0; gi < 4; ++gi) {
        if (gi < 3) {
#pragma unroll
            for (int i = 0; i < 4; ++i) A[(gi + 1) & 1][i] = *(const LAS bf16x8*)(vp + ((gi + 1) * 2 + (i >> 1)) * 16 * VROW + (i & 1) * 16);
        }
#pragma unroll
        for (int i = 0; i < 4; ++i) {
            const int dt = gi * 2 + (i >> 1), m = i & 1;
            O[0][dt] = MFMA16(A[gi & 1][i], P[0][m], O[0][dt]); O[1][dt] = MFMA16(A[gi & 1][i], P[1][m], O[1][dt]);
        }
    }
}
__device__ __forceinline__ void pack_p4(const f32x4 (&a)[4], bf16x8 (&P)[2]) {
    u32x4 w0, w1;
    w0.x = cvt_pk_bf16(a[0][0], a[0][1]); w0.y = cvt_pk_bf16(a[0][2], a[0][3]); w0.z = cvt_pk_bf16(a[1][0], a[1][1]); w0.w = cvt_pk_bf16(a[1][2], a[1][3]);
    w1.x = cvt_pk_bf16(a[2][0], a[2][1]); w1.y = cvt_pk_bf16(a[2][2], a[2][3]); w1.z = cvt_pk_bf16(a[3][0], a[3][1]); w1.w = cvt_pk_bf16(a[3][2], a[3][3]);
    P[0] = as_bf16x8(w0); P[1] = as_bf16x8(w1);
}
__device__ __forceinline__ int next_ticket(unsigned* ctr, volatile LAS int* slot) {
    __syncthreads();
    if (threadIdx.x == 0) *slot = (int)__hip_atomic_fetch_add(ctr, 1u, __ATOMIC_RELAXED, __HIP_MEMORY_SCOPE_AGENT);
    __syncthreads();
    return *slot;
}
__device__ __forceinline__ unsigned ticket_request(unsigned* ctr) { return threadIdx.x == 0 ? __hip_atomic_fetch_add(ctr, 1u, __ATOMIC_RELAXED, __HIP_MEMORY_SCOPE_AGENT) : 0u; }
__device__ __forceinline__ int ticket_publish(unsigned v, volatile LAS int* slot) {
    __syncthreads();
    if (threadIdx.x == 0) *slot = (int)v;
    __syncthreads();
    return *slot;
}


__device__ __forceinline__ void sb_elementwise_robust(f32x4 (&S)[2][4], bf16x8 (&P)[2][2], float (&Prun)[2], int s0, int tw_lo, int r, int q) {
#pragma unroll
    for (int ct = 0; ct < 2; ++ct) {
        const int tq = tw_lo + ct * 16 + r;
        float e = 1.0f;
        if (s0 + 63 < tw_lo) {
#pragma unroll
            for (int i = 15; i >= 0; --i) {
                const float kp = frcp(1.0f + fexp2(S[ct][i >> 2][i & 3]));
                S[ct][i >> 2][i & 3] = (1.0f - kp) * e;
                e *= kp;
            }
        } else {
#pragma unroll
            for (int i = 15; i >= 0; --i) {
                const int s = s0 + 16 * q + i;
                const float kp = frcp(1.0f + fexp2(S[ct][i >> 2][i & 3]));
                const bool before = s < tq;
                S[ct][i >> 2][i & 3] = before ? (1.0f - kp) * e : 0.0f;
                e = before ? e * kp : e;
            }
        }
        const float a1 = __shfl_xor(e, 16), pp = e * a1, b1 = __shfl_xor(pp, 32);
        const float sfx = (q == 0) ? a1 * b1 : (q == 1) ? b1 : (q == 2) ? a1 : 1.0f;
        const float mult = sfx * Prun[ct];
        Prun[ct] *= pp * b1;
#pragma unroll
        for (int n = 0; n < 4; ++n) { S[ct][n][0] *= mult; S[ct][n][1] *= mult; S[ct][n][2] *= mult; S[ct][n][3] *= mult; }
        pack_p4(S[ct], P[ct]);
    }
}
__device__ __forceinline__ void sb_elementwise(f32x4 (&S)[2][4], bf16x8 (&P)[2][2], float (&Prun)[2], int s0, int tw_lo, int r, int q) {
    float mx = S[0][0][0];
#pragma unroll
    for (int ct = 0; ct < 2; ++ct)
#pragma unroll
        for (int n = 0; n < 4; ++n) mx = fmaxf(fmaxf(mx, fmaxf(S[ct][n][0], S[ct][n][1])), fmaxf(S[ct][n][2], S[ct][n][3]));
    if (__builtin_amdgcn_ballot_w64(!(mx <= 7.0f)) != 0ull) { sb_elementwise_robust(S, P, Prun, s0, tw_lo, r, q); return; }
#pragma unroll
    for (int ct = 0; ct < 2; ++ct) {
        const int tq = tw_lo + ct * 16 + r;
        float H = 1.0f;
        if (s0 + 63 < tw_lo) {
#pragma unroll
            for (int i = 0; i < 16; ++i) { const float t = fexp2(S[ct][i >> 2][i & 3]) * H; H += t; S[ct][i >> 2][i & 3] = t; }
        } else {
#pragma unroll
            for (int i = 0; i < 16; ++i) {
                const float x = (s0 + 16 * q + i < tq) ? fexp2(S[ct][i >> 2][i & 3]) : 0.0f;
                const float t = x * H; H += t; S[ct][i >> 2][i & 3] = t;
            }
        }
        const float e = frcp(H);
        const float a1 = __shfl_xor(e, 16), pp = e * a1, b1 = __shfl_xor(pp, 32);
        const float sfx = (q == 0) ? a1 * b1 : (q == 1) ? b1 : (q == 2) ? a1 : 1.0f;
        const float c = e * sfx * Prun[ct];
        Prun[ct] *= pp * b1;
#pragma unroll
        for (int n = 0; n < 4; ++n) { S[ct][n][0] *= c; S[ct][n][1] *= c; S[ct][n][2] *= c; S[ct][n][3] *= c; }
        pack_p4(S[ct], P[ct]);
    }
}
constexpr int KDB = 16384, VDB = 16384;
__device__ __forceinline__ void dma_kv_offsets(int tid, unsigned ldkB, unsigned ldvB, unsigned& koff, unsigned& voff) {
    const int w = tid >> 6, l = tid & 63;
    const int R = 4 * w + (l >> 4), p = l & 15;
    const int kx = ((R >> 2) & 3) * 16 + (R >> 4) * 4 + (R & 3);
    koff = (unsigned)kx * ldkB + (unsigned)((p ^ (R & 15)) * 16);
    const int d = 8 * w + (l >> 3), pv = l & 7;
    voff = (unsigned)d * ldvB + (unsigned)((pv ^ (((d >> 1) & 1) | (((d >> 3) & 1) << 2))) * 16);
}
__device__ __forceinline__ void dma_k(const bf16_t* kblk, unsigned ldkB, unsigned koff, LAS unsigned char* dst, unsigned ldsw) {
#pragma unroll
    for (int i = 0; i < 2; ++i)
        __builtin_amdgcn_global_load_lds((const unsigned*)((const char*)kblk + koff + (size_t)i * 8 * ldkB), (LAS unsigned*)(dst + ldsw + i * 8192), 16, 0, 0);
}
__device__ __forceinline__ void dma_v(const bf16_t* vblk, unsigned ldvB, unsigned voff, LAS unsigned char* dst, unsigned ldsw) {
#pragma unroll
    for (int i = 0; i < 2; ++i)
        __builtin_amdgcn_global_load_lds((const unsigned*)((const char*)vblk + voff + (size_t)i * 64 * ldvB), (LAS unsigned*)(dst + ldsw + i * 8192), 16, 0, 0);
}
#define SGB_PIPE4x8() do { __builtin_amdgcn_sched_group_barrier(0x100, 4, 0); _Pragma("unroll") for (int g_ = 0; g_ < 3; ++g_) { _Pragma("unroll") for (int h_ = 0; h_ < 4; ++h_) { \
        __builtin_amdgcn_sched_group_barrier(0x008, 2, 0); __builtin_amdgcn_sched_group_barrier(0x100, 1, 0); } } __builtin_amdgcn_sched_group_barrier(0x008, 8, 0); } while (0)
__device__ __forceinline__ void qk_block2d(const LAS unsigned char* Kl, const bf16x8 (&Bq)[2][4], f32x4 (&S)[2][4], int r, int q) {
    const int base = r * 256 + ((q ^ (r & 3)) * 16), xk = (r >> 2) * 64;
    const LAS unsigned char* kp[4];
#pragma unroll
    for (int kk = 0; kk < 4; ++kk) kp[kk] = Kl + base + ((kk * 64) ^ xk);
    bf16x8 A[2][4];
#pragma unroll
    for (int kk = 0; kk < 4; ++kk) A[0][kk] = *(const LAS bf16x8*)(kp[kk]);
#pragma unroll
    for (int n = 0; n < 4; ++n) {
        if (n < 3) {
#pragma unroll
            for (int kk = 0; kk < 4; ++kk) A[(n + 1) & 1][kk] = *(const LAS bf16x8*)(kp[kk] + (n + 1) * 4096);
        }
        S[0][n] = (f32x4){0.f, 0.f, 0.f, 0.f}; S[1][n] = (f32x4){0.f, 0.f, 0.f, 0.f};
#pragma unroll
        for (int kk = 0; kk < 4; ++kk) { S[0][n] = MFMA16(A[n & 1][kk], Bq[0][kk], S[0][n]); S[1][n] = MFMA16(A[n & 1][kk], Bq[1][kk], S[1][n]); }
    }
    SGB_PIPE4x8();
}
__device__ __forceinline__ void pv_block2d(const LAS unsigned char* Vl, const bf16x8 (&P)[2][2], f32x4 (&O)[2][8], int r, int q) {
    const LAS unsigned char* vp[2];
#pragma unroll
    for (int m = 0; m < 2; ++m) vp[m] = Vl + r * 128 + (((q * 2 + m) ^ (((r >> 1) & 1) | (((r >> 3) & 1) << 2))) * 16);
    bf16x8 A[2][4];
#pragma unroll
    for (int i = 0; i < 4; ++i) A[0][i] = *(const LAS bf16x8*)(vp[i & 1] + (i >> 1) * 2048);
#pragma unroll
    for (int gi = 0; gi < 4; ++gi) {
        if (gi < 3) {
#pragma unroll
            for (int i = 0; i < 4; ++i) A[(gi + 1) & 1][i] = *(const LAS bf16x8*)(vp[i & 1] + ((gi + 1) * 2 + (i >> 1)) * 2048);
        }
#pragma unroll
        for (int i = 0; i < 4; ++i) {
            const int dt = gi * 2 + (i >> 1), m = i & 1;
            O[0][dt] = MFMA16(A[gi & 1][i], P[0][m], O[0][dt]); O[1][dt] = MFMA16(A[gi & 1][i], P[1][m], O[1][dt]);
        }
    }
    SGB_PIPE4x8();
}
__device__ __forceinline__ void sb_qblock4(const Args& a, int b, int h, int qb, LAS unsigned char* lds) {
    unsigned char* ws = a.ws;
    int tid_ = threadIdx.x; asm volatile("" : "+v"(tid_));
    const int tid = tid_, lane = tid & 63, wave = __builtin_amdgcn_readfirstlane(tid >> 6), r = lane & 15, q = lane >> 4;
    const int t0 = qb * 256, tw_lo = t0 + wave * 32, tw_hi = tw_lo + 31;
    bf16x8 Bq[2][4];
#pragma unroll
    for (int ct = 0; ct < 2; ++ct) load_q((const bf16_t*)(ws + WS_QSB) + (size_t)(b * NT + tw_lo + ct * 16 + r) * 1024 + h * 128, QSCALE, Bq[ct], q);
    const bf16_t* kbase = (const bf16_t*)(ws + WS_KSB) + (size_t)(b * 8 + h) * NT * 128;
    const bf16_t* vbase = (const bf16_t*)(ws + WS_VSBT) + (size_t)(b * 8 + h) * 64 * 8192;
    f32x4 O[2][8];
#pragma unroll
    for (int ct = 0; ct < 2; ++ct)
#pragma unroll
        for (int i = 0; i < 8; ++i) O[ct][i] = (f32x4){0.f, 0.f, 0.f, 0.f};
    float Prun[2] = {1.0f, 1.0f};
    const int nblk = 4 * qb + 4;
    LAS unsigned char* kb0 = lds; LAS unsigned char* vb0 = lds + 2 * KDB;
    unsigned koff, voff; dma_kv_offsets(tid, 256u, 128u, koff, voff);
    const unsigned ldsw = (unsigned)wave * 1024u;
    dma_k(kbase + (size_t)(nblk - 1) * 8192, 256u, koff, kb0, ldsw);
    dma_v(vbase + (size_t)(nblk - 1) * 8192, 128u, voff, vb0, ldsw);
    dma_k(kbase + (size_t)(nblk - 2) * 8192, 256u, koff, kb0 + KDB, ldsw);
    asm volatile("s_waitcnt vmcnt(0)" ::: "memory");
    __syncthreads();
    f32x4 S[2][4]; bf16x8 P[2][2];
#define SB_DMA(J) do { const int j_ = (J); \
        if (j_ + 2 < nblk) dma_k(kbase + (size_t)(nblk - 3 - j_) * 8192, 256u, koff, kb0 + (j_ & 1) * KDB, ldsw); \
        if (j_ + 1 < nblk) dma_v(vbase + (size_t)(nblk - 2 - j_) * 8192, 128u, voff, vb0 + ((j_ + 1) & 1) * VDB, ldsw); } while (0)
#define SB_EW(J) do { const int s0_ = (nblk - 1 - (J)) * 64; if (s0_ < tw_hi) sb_elementwise(S, P, Prun, s0_, tw_lo, r, q); } while (0)
#define SB_M(J) do { const int j_ = (J), s0_ = (nblk - 1 - j_) * 64; \
        if (s0_ < tw_hi) pv_block2d(vb0 + (j_ & 1) * VDB, P, O, r, q); \
        if (j_ + 1 < nblk && (s0_ - 64) < tw_hi) qk_block2d(kb0 + ((j_ + 1) & 1) * KDB, Bq, S, r, q); } while (0)
    if (wave < 4) {
        if ((nblk - 1) * 64 < tw_hi) qk_block2d(kb0, Bq, S, r, q);
        __syncthreads();
        for (int j = 0; j < nblk; ++j) {
            SB_EW(j);
            asm volatile("s_waitcnt vmcnt(0)" ::: "memory");
            __syncthreads();
            SB_DMA(j);
            SB_M(j);
            __syncthreads();
        }
        __syncthreads();
    } else {
        __syncthreads();
        if ((nblk - 1) * 64 < tw_hi) qk_block2d(kb0, Bq, S, r, q);
        __syncthreads();
        for (int j = 0; j < nblk; ++j) {
            SB_DMA(j);
            SB_EW(j);
            __syncthreads();
            SB_M(j);
            asm volatile("s_waitcnt vmcnt(0)" ::: "memory");
            __syncthreads();
        }
    }
#undef SB_DMA
#undef SB_EW
#undef SB_M
#pragma unroll
    for (int ct = 0; ct < 2; ++ct) {
        bf16_t* op = (bf16_t*)(ws + WS_ORAW) + (size_t)(b * NT + tw_lo + ct * 16 + r) * DM + h * 128 + q * 4;
        float ss = 0.f;
#pragma unroll
        for (int dt = 0; dt < 8; ++dt) {
            u32x2 w; w.x = cvt_pk_bf16(O[ct][dt][0], O[ct][dt][1]); w.y = cvt_pk_bf16(O[ct][dt][2], O[ct][dt][3]); *(u32x2*)(op + dt * 16) = w;
            ss += bf_lo(w.x) * bf_lo(w.x) + bf_hi(w.x) * bf_hi(w.x) + bf_lo(w.y) * bf_lo(w.y) + bf_hi(w.y) * bf_hi(w.y);
        }
        ss = row4_sum_f32(ss);
        if (q == 0) ((float*)(ws + WS_SS))[(size_t)h * NTOK + b * NT + tw_lo + ct * 16 + r] = ss;
    }
}

__device__ __forceinline__ void compress_item(const Args& a, int item, LAS unsigned char* lds) {
    unsigned char* ws = a.ws;
    int tid_ = threadIdx.x; asm volatile("" : "+v"(tid_));
    const int tid = tid_, lane = tid & 63, wave = __builtin_amdgcn_readfirstlane(tid >> 6), r = lane & 15, q = lane >> 4;
    const int kv = item >> 6, bg = (item >> 2) & 15, cc = item & 3, b = bg >> 1, g = bg & 1;
    const bf16_t* X = (const bf16_t*)(ws + (kv ? WS_VCI : WS_KCI)) + (size_t)b * NT * 256 + g * 128;
    const bf16_t* W1 = (const bf16_t*)(ws + WS_CW1) + (size_t)kv * 256 * 4096;
    const bf16_t* W2 = (const bf16_t*)(ws + WS_CW2) + (size_t)kv * 128 * 256;
    const float* cb = (const float*)(ws + WS_CB) + kv * 256;
    constexpr int HROW = 528;
    LAS unsigned char* Hs = lds; LAS float* Os = (LAS float*)(lds + 64 * HROW);
    f32x4 acc[2][4];
#pragma unroll
    for (int i = 0; i < 2; ++i)
#pragma unroll
        for (int j = 0; j < 4; ++j) acc[i][j] = (f32x4){0.f, 0.f, 0.f, 0.f};
    const bf16_t* xr[4];
#pragma unroll
    for (int ct = 0; ct < 4; ++ct) { int c = cc * 64 + ct * 16 + r; c = c > 254 ? 254 : c; xr[ct] = X + (size_t)(16 * c) * 256 + q * 8; }
    const bf16_t* w1r0 = W1 + (size_t)(wave * 32 + r) * 4096 + q * 8;
    const bf16_t* w1r1 = w1r0 + (size_t)16 * 4096;
#pragma unroll 4
    for (int ks = 0; ks < 128; ++ks) {
        const int xo = (ks >> 2) * 256 + (ks & 3) * 32;
        const bf16x8 A0 = *(const bf16x8*)(w1r0 + ks * 32), A1 = *(const bf16x8*)(w1r1 + ks * 32);
#pragma unroll
        for (int ct = 0; ct < 4; ++ct) { const bf16x8 Bf = *(const bf16x8*)(xr[ct] + xo); acc[0][ct] = MFMA16(A0, Bf, acc[0][ct]); acc[1][ct] = MFMA16(A1, Bf, acc[1][ct]); }
    }
#pragma unroll
    for (int nt = 0; nt < 2; ++nt) {
        const int n0 = wave * 32 + nt * 16 + q * 4;
        const f32x4 bias = {__hip_atomic_load(cb + n0, __ATOMIC_RELAXED, __HIP_MEMORY_SCOPE_AGENT), __hip_atomic_load(cb + n0 + 1, __ATOMIC_RELAXED, __HIP_MEMORY_SCOPE_AGENT),
                            __hip_atomic_load(cb + n0 + 2, __ATOMIC_RELAXED, __HIP_MEMORY_SCOPE_AGENT), __hip_atomic_load(cb + n0 + 3, __ATOMIC_RELAXED, __HIP_MEMORY_SCOPE_AGENT)};
#pragma unroll
        for (int ct = 0; ct < 4; ++ct) {
            const f32x4 v = acc[nt][ct] + bias;
            u32x2 w; w.x = cvt_pk_bf16(gelu_tanh(v[0]), gelu_tanh(v[1])); w.y = cvt_pk_bf16(gelu_tanh(v[2]), gelu_tanh(v[3]));
            *(LAS u32x2*)(Hs + (ct * 16 + r) * HROW + n0 * 2) = w;
        }
    }
    __syncthreads();
    f32x4 acc2[4];
#pragma unroll
    for (int j = 0; j < 4; ++j) acc2[j] = (f32x4){0.f, 0.f, 0.f, 0.f};
    const bf16_t* w2r = W2 + (size_t)(wave * 16 + r) * 256 + q * 8;
#pragma unroll
    for (int k2 = 0; k2 < 8; ++k2) {
        const bf16x8 A2 = *(const bf16x8*)(w2r + k2 * 32);
#pragma unroll
        for (int ct = 0; ct < 4; ++ct) { const bf16x8 B2 = *(const LAS bf16x8*)(Hs + (ct * 16 + r) * HROW + (k2 * 32 + q * 8) * 2); acc2[ct] = MFMA16(A2, B2, acc2[ct]); }
    }
#pragma unroll
    for (int ct = 0; ct < 4; ++ct) *(LAS f32x4*)(Os + (ct * 16 + r) * 132 + wave * 16 + q * 4) = acc2[ct];
    __syncthreads();
    {
        const int row = tid >> 3, part = tid & 7, c = cc * 64 + row;
        float v[16]; float ss = 0.f;
#pragma unroll
        for (int e = 0; e < 16; ++e) { v[e] = Os[row * 132 + part * 16 + e]; ss += v[e] * v[e]; }
        if (kv == 0) {
            ss += __shfl_xor(ss, 1); ss += __shfl_xor(ss, 2); ss += __shfl_xor(ss, 4);
            const float rstd = rsqrtf(ss * (1.0f / 128.0f) + EPS);
            const float* kg = a.in[9] + part * 16;
#pragma unroll
            for (int e = 0; e < 16; ++e) v[e] = (c == 255) ? 0.f : v[e] * rstd * kg[e];
            bf16_t* o = (bf16_t*)(ws + WS_KC) + ((size_t)bg * 256 + c) * 128 + part * 16;
            u32x4 w0, w1;
            w0.x = cvt_pk_bf16(v[0], v[1]); w0.y = cvt_pk_bf16(v[2], v[3]); w0.z = cvt_pk_bf16(v[4], v[5]); w0.w = cvt_pk_bf16(v[6], v[7]);
            w1.x = cvt_pk_bf16(v[8], v[9]); w1.y = cvt_pk_bf16(v[10], v[11]); w1.z = cvt_pk_bf16(v[12], v[13]); w1.w = cvt_pk_bf16(v[14], v[15]);
            *(u32x4*)o = w0; *(u32x4*)(o + 8) = w1;
        } else {
            bf16_t* o = (bf16_t*)(ws + WS_VCT) + ((size_t)bg * 128 + part * 16) * 256 + c;
#pragma unroll
            for (int e = 0; e < 16; ++e) { const float x = (c == 255) ? 0.f : v[e]; o[(size_t)e * 256] = (bf16_t)(cvt_pk_bf16(x, 0.f) & 0xffffu); }
        }
    }
    __syncthreads();
}

__device__ __forceinline__ void fixup_item(const Args& a, int item) {
    unsigned char* ws = a.ws;
    int tid_ = threadIdx.x; asm volatile("" : "+v"(tid_));
    const int tid = tid_, grp = tid >> 4, sub = tid & 15;
    f32x4 gk0 = *(const f32x4*)(a.in[9] + sub * 8), gk1 = *(const f32x4*)(a.in[9] + sub * 8 + 4);
    for (int it = 0; it < 16; ++it) {
        const int hr = grp + it * 32, tok = item * 128 + (hr >> 2), hd = 8 + (hr & 3);
        const bf16_t* p; bf16_t* po; f32x4 g0, g1; float sc;
        if (hd < 10) { const size_t o = (size_t)tok * 256 + (hd - 8) * 128 + sub * 8; p = (const bf16_t*)(ws + WS_KSL) + o; po = (bf16_t*)(ws + WS_KSL2) + ((size_t)((tok >> 12) * 2 + (hd - 8)) * NT + (tok & 4095)) * 128 + sub * 8; g0 = gk0; g1 = gk1; sc = 1.0f; }
        else { const size_t o = (size_t)tok * 256 + (hd - 10) * 128 + sub * 8; p = (const bf16_t*)(ws + WS_KWI) + o; po = (bf16_t*)(ws + WS_KWI2) + ((size_t)((tok >> 12) * 2 + (hd - 10)) * NT + (tok & 4095)) * 128 + sub * 8; g0 = gk0; g1 = gk1; sc = 1.0f; }
        const u32x4 raw = *(const u32x4*)p;
        float f[8] = {bf_lo(raw.x), bf_hi(raw.x), bf_lo(raw.y), bf_hi(raw.y), bf_lo(raw.z), bf_hi(raw.z), bf_lo(raw.w), bf_hi(raw.w)};
        float ss = 0.f;
#pragma unroll
        for (int e = 0; e < 8; ++e) ss += f[e] * f[e];
        ss += __shfl_xor(ss, 1); ss += __shfl_xor(ss, 2); ss += __shfl_xor(ss, 4); ss += __shfl_xor(ss, 8);
        const float rstd = rsqrtf(ss * (1.0f / 128.0f) + EPS) * sc;
        u32x4 w;
        w.x = cvt_pk_bf16(f[0] * rstd * g0[0], f[1] * rstd * g0[1]); w.y = cvt_pk_bf16(f[2] * rstd * g0[2], f[3] * rstd * g0[3]);
        w.z = cvt_pk_bf16(f[4] * rstd * g1[0], f[5] * rstd * g1[1]); w.w = cvt_pk_bf16(f[6] * rstd * g1[2], f[7] * rstd * g1[3]);
        *(u32x4*)po = w;
    }
}

enum { MODE_CMP = 0, MODE_SLC = 1, MODE_WIN = 2 };

constexpr int NS2_IMP = 2 * ABUF;
constexpr int NS2_SEL = NS2_IMP + 64 * 65 * 4;
constexpr int NS2_LUT = NS2_SEL + 64 * 2 * 4;
constexpr int NS2_TKT = NS2_LUT + 4 * 256 * 4;

template <int MODE>
__device__ __forceinline__ void score_tile2(f32x4 (&S)[4], int tq, int idx0, int q, bool selok, const LAS float* lut) {
#pragma unroll
    for (int n = 0; n < 4; ++n)
#pragma unroll
        for (int j = 0; j < 4; ++j) {
            const int s = idx0 + 16 * q + 4 * n + j;
            int dist; bool valid;
            if (MODE == MODE_CMP) { dist = tq - (16 * s + 31); valid = dist >= 0; }
            else if (MODE == MODE_SLC) { dist = tq - s; valid = selok && dist >= 0; }
            else { dist = tq - s; valid = dist >= 0 && dist < 512; }
            int di = dist < 0 ? 0 : dist; di = di > 128 ? 128 : di;
            const float v = S[n][j] + lut[di];
            S[n][j] = valid ? v : -INFINITY;
        }
}
__device__ __forceinline__ void score_near(f32x4 (&S)[4], int D0, bool selok, const LAS float* lut) {
    const LAS float* eb = lut + (D0 - 15);
    const int dl = selok ? D0 : -1;
#pragma unroll
    for (int i = 0; i < 16; ++i) { const float v = S[i >> 2][i & 3] + eb[15 - i]; S[i >> 2][i & 3] = (i <= dl) ? v : -INFINITY; }
}
__device__ __forceinline__ void score_edge(f32x4 (&S)[4], int D0, float cb) {
    const int lim = D0 - 512;
#pragma unroll
    for (int i = 0; i < 16; ++i) { const float v = S[i >> 2][i & 3] + cb; S[i >> 2][i & 3] = (i > lim) ? v : -INFINITY; }
}
__device__ __forceinline__ float online_stats(f32x4 (&S)[4], float& m, float& l) {
    float mx = -INFINITY;
#pragma unroll
    for (int n = 0; n < 4; ++n) mx = fmaxf(fmaxf(mx, fmaxf(S[n][0], S[n][1])), fmaxf(S[n][2], S[n][3]));
    mx = row4_max_f32(mx);
    const float mnew = fmaxf(m, mx);
    const float msafe = (mnew == -INFINITY) ? 0.0f : mnew;
    const float alpha = fexp2(m - msafe);
    float rs = 0.f;
#pragma unroll
    for (int n = 0; n < 4; ++n)
#pragma unroll
        for (int j = 0; j < 4; ++j) { const float p = fexp2(S[n][j] - msafe); S[n][j] = p; rs += p; }
    rs = row4_sum_f32(rs);
    l = l * alpha + rs; m = mnew;
    return alpha;
}

__device__ __forceinline__ float online_stats_far(f32x4 (&S)[4], float& m, float& l, float cb, bool selok) {
    float mx = -INFINITY;
#pragma unroll
    for (int n = 0; n < 4; ++n) mx = fmaxf(fmaxf(mx, fmaxf(S[n][0], S[n][1])), fmaxf(S[n][2], S[n][3]));
    mx = row4_max_f32(mx);
    const float mnew = selok ? fmaxf(m, mx + cb) : m;
    const float msafe = (mnew == -INFINITY) ? 0.0f : mnew;
    const float alpha = fexp2(m - msafe);
    const float off = selok ? cb - msafe : -INFINITY;
    float rs = 0.f;
#pragma unroll
    for (int n = 0; n < 4; ++n)
#pragma unroll
        for (int j = 0; j < 4; ++j) { const float p = fexp2(S[n][j] + off); S[n][j] = p; rs += p; }
    rs = row4_sum_f32(rs);
    l = l * alpha + rs; m = mnew;
    return alpha;
}
__device__ __forceinline__ void nsa_probs(f32x4 (&S)[4], float& l, float mref, bool keep, bf16x8 (&P)[2]) {
    if (__builtin_amdgcn_ballot_w64(mref != 0.0f) != 0ull) {
#pragma unroll
        for (int n = 0; n < 4; ++n) { S[n][0] -= mref; S[n][1] -= mref; S[n][2] -= mref; S[n][3] -= mref; }
    }
    float rs = 0.f;
#pragma unroll
    for (int n = 0; n < 4; ++n)
#pragma unroll
        for (int j = 0; j < 4; ++j) { const float p = fexp2(S[n][j]); S[n][j] = p; rs += p; }
    pack_p4(S, P);
    if (!keep) { const bf16x8 z = {0, 0, 0, 0, 0, 0, 0, 0}; P[0] = z; P[1] = z; rs = 0.f; }
    l += rs;
}
__device__ __forceinline__ void nsa_flush(bf16_t* op0, bf16_t* op1, f32x4 (&O)[2][8], const float (&sc)[2], bool first, float* ssq = nullptr) {
#pragma unroll
    for (int ct = 0; ct < 2; ++ct) {
        bf16_t* op = ct ? op1 : op0;
#pragma unroll
        for (int dt = 0; dt < 8; ++dt) {
            float v0 = sc[ct] * O[ct][dt][0], v1 = sc[ct] * O[ct][dt][1], v2 = sc[ct] * O[ct][dt][2], v3 = sc[ct] * O[ct][dt][3];
            if (!first) { const u32x2 old = *(const u32x2*)(op + dt * 16); v0 += bf_lo(old.x); v1 += bf_hi(old.x); v2 += bf_lo(old.y); v3 += bf_hi(old.y); }
            u32x2 w; w.x = cvt_pk_bf16(v0, v1); w.y = cvt_pk_bf16(v2, v3);
            *(u32x2*)(op + dt * 16) = w;
            if (ssq) ssq[ct] += bf_lo(w.x) * bf_lo(w.x) + bf_hi(w.x) * bf_hi(w.x) + bf_lo(w.y) * bf_lo(w.y) + bf_hi(w.y) * bf_hi(w.y);
        }
    }
}

__device__ __forceinline__ void nsa_item2(const Args& a, int item, LAS unsigned char* lds) {
    unsigned char* ws = a.ws;
    int tid_ = threadIdx.x; asm volatile("" : "+v"(tid_));
    const int tid = tid_, lane = tid & 63, wave = __builtin_amdgcn_readfirstlane(tid >> 6), r = lane & 15, q = lane >> 4;
    const int b = item >> 7, g = (item >> 6) & 1, qi = item & 63;
    const int hr = wave >> 1, qh = wave & 1;
    const int t0 = qi * 64, cur = qi, tw = t0 + qh * 32;
    const int bg = b * 2 + g;
    LAS unsigned* imp = (LAS unsigned*)(lds + NS2_IMP);
    LAS unsigned* sel = (LAS unsigned*)(lds + NS2_SEL);
    LAS float* lutall = (LAS float*)(lds + NS2_LUT);
    for (int i = tid; i < 4 * 256; i += 512) {
        const int hh = i >> 8, dr = (i & 255) - 64, d = dr < 0 ? 0 : dr;
        int bucket;
        if (d < 16) bucket = d;
        else { const int lg = (int)(__log2f((float)d * (1.0f / 16.0f)) * (16.0f / 3.0f)); bucket = 16 + lg; bucket = bucket > 31 ? 31 : bucket; }
        if (d >= 128) bucket = 31;
        lutall[i] = (a.in[10][bucket * 8 + g * 4 + hh] - a.in[10][31 * 8 + g * 4 + hh]) * LOG2E;
    }
    for (int i = tid; i < 64 * 65; i += 512) imp[i] = 0u;
    if (tid < 128) sel[tid] = 0u;
    const LAS float* lut = lutall + hr * 256 + 64;
    bf16x8 Bq[2][4];
    float gate[2][3];
    bf16_t* op[2];
#pragma unroll
    for (int ct = 0; ct < 2; ++ct) {
        const size_t row = (size_t)(b * NT + tw + ct * 16 + r);
        load_q_norm((const bf16_t*)(ws + WS_QN) + row * 1024 + (g * 4 + hr) * 128, a.in[8], Bq[ct], q);
        const bf16_t* gp = (const bf16_t*)(ws + WS_GT) + row * 32 + g * 12 + hr * 3;
#pragma unroll
        for (int i = 0; i < 3; ++i) { const float x = __uint_as_float(((unsigned)gp[i]) << 16); gate[ct][i] = frcp(1.0f + fexp2(-x * LOG2E)); }
        op[ct] = (bf16_t*)(ws + WS_ORAW) + row * DM + 1024 + (g * 4 + hr) * 128 + q * 4;
    }
    f32x4 O[2][8];
    Stage st;
    __syncthreads();
    float mref[2];
    {
        float gm = fmaxf(fabsf(a.in[9][lane * 2]), fabsf(a.in[9][lane * 2 + 1]));
        float bm = 0.f;
        for (int d = lane; d <= 128; d += 64) bm = fmaxf(bm, lut[d]);
#pragma unroll
        for (int o = 32; o > 0; o >>= 1) { gm = fmaxf(gm, __shfl_xor(gm, o)); bm = fmaxf(bm, __shfl_xor(bm, o)); }
#pragma unroll
        for (int ct = 0; ct < 2; ++ct) {
            float ss = 0.f;
#pragma unroll
            for (int kk = 0; kk < 4; ++kk) {
                const u32x4 w = __builtin_bit_cast(u32x4, Bq[ct][kk]);
                ss += bf_lo(w.x) * bf_lo(w.x) + bf_hi(w.x) * bf_hi(w.x) + bf_lo(w.y) * bf_lo(w.y) + bf_hi(w.y) * bf_hi(w.y)
                    + bf_lo(w.z) * bf_lo(w.z) + bf_hi(w.z) * bf_hi(w.z) + bf_lo(w.w) * bf_lo(w.w) + bf_hi(w.w) * bf_hi(w.w);
            }
            ss = row4_sum_f32(ss);
            mref[ct] = fmaxf(0.0f, sqrtf(ss) * 11.3137085f * gm * 1.01f + bm - 64.0f);
        }
    }
    {
        const bf16_t* kbase = (const bf16_t*)(ws + WS_KC) + (size_t)bg * 256 * 128;
        const bf16_t* vbase = (const bf16_t*)(ws + WS_VCT) + (size_t)bg * 128 * 256;
        const int ncb = ((t0 + 32) >> 4) / 64 + 1;
        float m[2] = {-INFINITY, -INFINITY}, l[2] = {0.f, 0.f};
        stage_load_k(st, kbase, 128, tid); stage_store(st, lds, tid, false); __syncthreads();
        for (int it = 0; it < ncb; ++it) {
            const LAS unsigned char* buf = lds + (it & 1) * ABUF;
            if (it + 1 < ncb) stage_load_k(st, kbase + (size_t)(it + 1) * 8192, 128, tid);
            f32x4 S[2][4]; qk_block2(buf, Bq, S, r, q);
#pragma unroll
            for (int ct = 0; ct < 2; ++ct) {
                if (tw >= 1024 * it + 1167) (void)online_stats_far(S[ct], m[ct], l[ct], lut[128], true);
                else { score_tile2<MODE_CMP>(S[ct], tw + ct * 16 + r, it * 64, q, true, lut); (void)online_stats(S[ct], m[ct], l[ct]); }
            }
            if (it + 1 < ncb) stage_store(st, lds + ((it + 1) & 1) * ABUF, tid, false);
            __syncthreads();
        }
        float msafe[2], invl[2];
#pragma unroll
        for (int ct = 0; ct < 2; ++ct) { msafe[ct] = (m[ct] == -INFINITY) ? 0.0f : m[ct]; invl[ct] = l[ct] > 0.f ? frcp(l[ct]) : 0.f; }
#pragma unroll
        for (int ct = 0; ct < 2; ++ct)
#pragma unroll
            for (int i = 0; i < 8; ++i) O[ct][i] = (f32x4){0.f, 0.f, 0.f, 0.f};
        stage_load(st, kbase, 128, vbase, 256, tid); stage_store(st, lds, tid, true); __syncthreads();
        for (int it = 0; it < ncb; ++it) {
            const LAS unsigned char* buf = lds + (it & 1) * ABUF;
            if (it + 1 < ncb) stage_load(st, kbase + (size_t)(it + 1) * 8192, 128, vbase + (it + 1) * 64, 256, tid);
            f32x4 S[2][4]; qk_block2(buf, Bq, S, r, q);
            bf16x8 P[2][2];
#pragma unroll
            for (int ct = 0; ct < 2; ++ct) {
                const bool farb = tw >= 1024 * it + 1167;
                if (!farb) score_tile2<MODE_CMP>(S[ct], tw + ct * 16 + r, it * 64, q, true, lut);
                const float offc = (farb ? lut[128] : 0.0f) - msafe[ct];
#pragma unroll
                for (int n = 0; n < 4; ++n) {
#pragma unroll
                    for (int j = 0; j < 4; ++j) S[ct][n][j] = fexp2(S[ct][n][j] + offc) * invl[ct];
                    const int nsel = it * 16 + 4 * q + n;
                    const float aa = S[ct][n][0] + S[ct][n][1] + S[ct][n][2] + 0.5f * S[ct][n][3], bb = 0.5f * S[ct][n][3];
                    LAS unsigned* ip = imp + (qh * 32 + ct * 16 + r) * 65 + nsel;
                    __hip_atomic_fetch_add(ip, (unsigned)(aa * 16777216.0f + 0.5f), __ATOMIC_RELAXED, __HIP_MEMORY_SCOPE_WORKGROUP);
                    __hip_atomic_fetch_add(ip + 1, (unsigned)(bb * 16777216.0f + 0.5f), __ATOMIC_RELAXED, __HIP_MEMORY_SCOPE_WORKGROUP);
                }
                pack_p4(S[ct], P[ct]);
            }
            pv_block2(buf + KBUF, P, O, r, q);
            if (it + 1 < ncb) stage_store(st, lds + ((it + 1) & 1) * ABUF, tid, true);
            __syncthreads();
        }
        const float sc[2] = {gate[0][0], gate[1][0]};
        nsa_flush(op[0], op[1], O, sc, true);
    }
    {
        const int qx = tid >> 3, tl = tid & 7;
        unsigned lo = 0u, hi = 0u;
        if (cur <= 15) { if (tl == 0) lo = (2u << cur) - 1u; }
        else {
            const LAS unsigned* iq = imp + qx * 65;
            for (int n = 1 + tl; n <= cur - 2; n += 8) {
                const unsigned v = iq[n]; int rank = 0;
                for (int mm = 1; mm <= cur - 2; ++mm) { const unsigned w = iq[mm]; rank += (w > v || (w == v && mm < n)) ? 1 : 0; }
                if (rank < 13) { if (n < 32) lo |= 1u << n; else hi |= 1u << (n - 32); }
            }
            if (tl == 0) { lo |= 1u; if (cur < 32) lo |= 1u << cur; else hi |= 1u << (cur - 32); if (cur - 1 < 32) lo |= 1u << (cur - 1); else hi |= 1u << (cur - 33); }
        }
        if (lo) __hip_atomic_fetch_or(sel + qx * 2, lo, __ATOMIC_RELAXED, __HIP_MEMORY_SCOPE_WORKGROUP);
        if (hi) __hip_atomic_fetch_or(sel + qx * 2 + 1, hi, __ATOMIC_RELAXED, __HIP_MEMORY_SCOPE_WORKGROUP);
    }
    __syncthreads();
    {
        unsigned ulo = 0u, uhi = 0u;
        for (int i = 0; i < 64; ++i) { ulo |= sel[i * 2]; uhi |= sel[i * 2 + 1]; }
        unsigned long long rem = ((unsigned long long)__builtin_amdgcn_readfirstlane(uhi) << 32) | (unsigned long long)__builtin_amdgcn_readfirstlane(ulo);
        unsigned long long myq[2];
#pragma unroll
        for (int ct = 0; ct < 2; ++ct) myq[ct] = ((unsigned long long)sel[(qh * 32 + ct * 16 + r) * 2 + 1] << 32) | (unsigned long long)sel[(qh * 32 + ct * 16 + r) * 2];
        const bf16_t* kbase = (const bf16_t*)(ws + WS_KSL2) + (size_t)bg * NT * 128;
        const bf16_t* vbase = (const bf16_t*)(ws + WS_VSLT) + (size_t)bg * 64 * 8192;
        float l[2] = {0.f, 0.f};
#pragma unroll
        for (int ct = 0; ct < 2; ++ct)
#pragma unroll
            for (int i = 0; i < 8; ++i) O[ct][i] = (f32x4){0.f, 0.f, 0.f, 0.f};
        int jb = __builtin_ctzll(rem); rem &= rem - 1;
        stage_load(st, kbase + (size_t)jb * 8192, 128, vbase + (size_t)jb * 8192, 64, tid); stage_store(st, lds, tid, true); __syncthreads();
        for (int it = 0;; ++it) {
            const LAS unsigned char* buf = lds + (it & 1) * ABUF;
            const bool more = rem != 0ull;
            int jn = 0;
            if (more) { jn = __builtin_ctzll(rem); rem &= rem - 1; stage_load(st, kbase + (size_t)jn * 8192, 128, vbase + (size_t)jn * 8192, 64, tid); }
            f32x4 S[2][4]; qk_block2(buf, Bq, S, r, q);
            bf16x8 P[2][2];
            if (jb + 3 <= cur) {
#pragma unroll
                for (int ct = 0; ct < 2; ++ct) nsa_probs(S[ct], l[ct], mref[ct], ((myq[ct] >> jb) & 1ull) != 0ull, P[ct]);
            } else {
#pragma unroll
                for (int ct = 0; ct < 2; ++ct) { score_near(S[ct], tw + ct * 16 + r - jb * 64 - 16 * q, ((myq[ct] >> jb) & 1ull) != 0ull, lut); nsa_probs(S[ct], l[ct], mref[ct], true, P[ct]); }
            }
            pv_block2(buf + KBUF, P, O, r, q);
            if (more) stage_store(st, lds + ((it + 1) & 1) * ABUF, tid, true);
            __syncthreads();
            if (!more) break;
            jb = jn;
        }
        const float lt0 = row4_sum_f32(l[0]), lt1 = row4_sum_f32(l[1]);
        const float sc[2] = {gate[0][1] * (lt0 > 0.f ? frcp(lt0) : 0.f), gate[1][1] * (lt1 > 0.f ? frcp(lt1) : 0.f)};
        nsa_flush(op[0], op[1], O, sc, false);
    }
    {
        const bf16_t* kbase = (const bf16_t*)(ws + WS_KWI2) + (size_t)bg * NT * 128;
        const bf16_t* vbase = (const bf16_t*)(ws + WS_VWIT) + (size_t)bg * 64 * 8192;
        const int jlo = cur > 8 ? cur - 8 : 0;
        const int nblk = cur - jlo + 1;
        float l[2] = {0.f, 0.f};
#pragma unroll
        for (int ct = 0; ct < 2; ++ct)
#pragma unroll
            for (int i = 0; i < 8; ++i) O[ct][i] = (f32x4){0.f, 0.f, 0.f, 0.f};
        stage_load(st, kbase + (size_t)jlo * 8192, 128, vbase + (size_t)jlo * 8192, 64, tid); stage_store(st, lds, tid, true); __syncthreads();
        for (int it = 0; it < nblk; ++it) {
            const LAS unsigned char* buf = lds + (it & 1) * ABUF;
            if (it + 1 < nblk) stage_load(st, kbase + (size_t)(jlo + it + 1) * 8192, 128, vbase + (size_t)(jlo + it + 1) * 8192, 64, tid);
            f32x4 S[2][4]; qk_block2(buf, Bq, S, r, q);
            bf16x8 P[2][2];
            const int jw = jlo + it;
            if (!(jw + 3 <= cur && jw + 8 > cur)) {
#pragma unroll
                for (int ct = 0; ct < 2; ++ct) {
                    const int D0 = tw + ct * 16 + r - jw * 64 - 16 * q;
                    if (jw + 3 > cur) score_near(S[ct], D0, true, lut); else score_edge(S[ct], D0, lut[128]);
                }
            }
#pragma unroll
            for (int ct = 0; ct < 2; ++ct) nsa_probs(S[ct], l[ct], mref[ct], true, P[ct]);
            pv_block2(buf + KBUF, P, O, r, q);
            if (it + 1 < nblk) stage_store(st, lds + ((it + 1) & 1) * ABUF, tid, true);
            __syncthreads();
        }
        const float lt0 = row4_sum_f32(l[0]), lt1 = row4_sum_f32(l[1]);
        const float sc[2] = {gate[0][2] * (lt0 > 0.f ? frcp(lt0) : 0.f), gate[1][2] * (lt1 > 0.f ? frcp(lt1) : 0.f)};
        float ssq[2] = {0.f, 0.f};
        nsa_flush(op[0], op[1], O, sc, false, ssq);
#pragma unroll
        for (int ct = 0; ct < 2; ++ct) {
            const float t = row4_sum_f32(ssq[ct]);
            if (q == 0) ((float*)(ws + WS_SS))[(size_t)(8 + g * 4 + hr) * NTOK + b * NT + tw + ct * 16 + r] = t;
        }
    }
    __syncthreads();
}

__device__ __forceinline__ void norm_mixed(const Args& a) {
    unsigned char* ws = a.ws;
    const float* ss = (const float*)(ws + WS_SS); float* rs = (float*)(ws + WS_RS);
    for (int tok = blockIdx.x * 512 + threadIdx.x; tok < NTOK; tok += gridDim.x * 512) {
        float s0 = 0.f, s1 = 0.f;
#pragma unroll
        for (int h = 0; h < 8; ++h) { s0 += ss[(size_t)h * NTOK + tok]; s1 += ss[(size_t)(8 + h) * NTOK + tok]; }
        *(f32x2*)(rs + (size_t)tok * 2) = (f32x2){rsqrtf(s0 * (1.0f / 1024.0f) + EPS), rsqrtf(s1 * (1.0f / 1024.0f) + EPS)};
    }
}

__device__ __forceinline__ constexpr int cand_i(int c) {
    return c < 16 ? 0 : c < 24 ? 1 : c < 29 ? 2 : c < 33 ? 3 : c < 36 ? 4 : c < 38 ? 5 : c < 40 ? 6 : c < 42 ? 7 : (c - 42 + 8);
}
__device__ __forceinline__ constexpr int cand_j(int c) {
    return c < 16 ? c : c < 24 ? c - 16 : c < 29 ? c - 24 : c < 33 ? c - 29 : c < 36 ? c - 33 : c < 38 ? c - 36 : c < 40 ? c - 38 : c < 42 ? c - 40 : 0;
}
__device__ __forceinline__ void peer_topk_task(const Args& a, int tile, int tg, int h, LAS unsigned char* lds, int lane_in) {
    unsigned char* ws = a.ws;
    int lane = lane_in; asm volatile("" : "+v"(lane));
    const int r = lane & 15, q = lane >> 4;
    const int tok = tile * 64 + tg * 16 + r;
    unsigned tsu[2][16];
#pragma unroll
    for (int p = 0; p < 2; ++p) {
        const bf16_t* qp = (const bf16_t*)(ws + WS_QP) + (size_t)tok * DM + h * 256 + p * 128 + q * 8;
        const bf16_t* kp = (const bf16_t*)(ws + WS_SUBK) + ((size_t)(h * 2 + p) * 128 + r) * 128 + q * 8;
        bf16x8 Bq[4];
#pragma unroll
        for (int kk = 0; kk < 4; ++kk) Bq[kk] = *(const bf16x8*)(qp + kk * 32);
        unsigned u[32];
#pragma unroll
        for (int kt = 0; kt < 8; ++kt) {
            f32x4 acc = (f32x4){0.f, 0.f, 0.f, 0.f};
#pragma unroll
            for (int kk = 0; kk < 4; ++kk) { const bf16x8 A = *(const bf16x8*)(kp + (size_t)kt * 16 * 128 + kk * 32); acc = MFMA16(A, Bq[kk], acc); }
#pragma unroll
            for (int j = 0; j < 4; ++j) u[kt * 4 + j] = (f2sort(acc[j]) & ~127u) | (unsigned)(127 - (kt * 16 + q * 4 + j));
        }
        bitonic_sort_desc<16, 32>(u, 0); bitonic_sort_desc<16, 32>(u, 16);
        unsigned t16[16];
#pragma unroll
        for (int i = 0; i < 16; ++i) t16[i] = u[i] > u[31 - i] ? u[i] : u[31 - i];
        bitonic_merge_desc<16>(t16);
#pragma unroll
        for (int st = 0; st < 2; ++st) {
            unsigned o16[16];
#pragma unroll
            for (int i = 0; i < 16; ++i) { const unsigned pv = st == 0 ? partner32(t16[15 - i], lane) : partner16(t16[15 - i], lane); o16[i] = t16[i] > pv ? t16[i] : pv; }
            bitonic_merge_desc<16>(o16);
#pragma unroll
            for (int i = 0; i < 16; ++i) t16[i] = o16[i];
        }
#pragma unroll
        for (int it = 0; it < 16; ++it) tsu[p][it] = t16[it];
    }
    unsigned cu[13]; int ce[13];
#pragma unroll
    for (int uu = 0; uu < 13; ++uu) {
        unsigned key = 0u; int ex = 0;
#pragma unroll
        for (int qq = 0; qq < 4; ++qq) {
            const int c = 4 * uu + qq;
            if (c < 50) {
                const int ci = cand_i(c), cj = cand_j(c);
                const float sum = sort2f(tsu[0][ci] & ~127u) + sort2f(tsu[1][cj] & ~127u);
                const unsigned k2 = (f2sort(sum) & ~255u) | (unsigned)(255 - (ci * 16 + cj));
                const int e = (127 - (int)(tsu[0][ci] & 127u)) * 128 + (127 - (int)(tsu[1][cj] & 127u));
                if (q == qq) { key = k2; ex = e; }
            }
        }
        cu[uu] = key; ce[uu] = ex;
    }
    float bs[16]; int be[16];
#pragma unroll
    for (int it = 0; it < 16; ++it) {
        unsigned m = cu[0];
#pragma unroll
        for (int uu = 1; uu < 13; ++uu) m = cu[uu] > m ? cu[uu] : m;
        m = row4_max_u32(m);
        unsigned bx = 0u;
#pragma unroll
        for (int uu = 0; uu < 13; ++uu) { const bool hit = cu[uu] == m; bx = hit ? (unsigned)ce[uu] : bx; cu[uu] = hit ? 0u : cu[uu]; }
        bx = row4_max_u32(bx);
        bs[it] = sort2f(m & ~255u); be[it] = (int)bx;
    }
    float ex[16], sum = 0.f;
#pragma unroll
    for (int k = 0; k < 16; ++k) { ex[k] = fexp2((bs[k] - bs[0]) * LOG2E); sum += ex[k]; }
    const float inv = frcp(sum);
    if (q == 0) {
        unsigned short* ei = (unsigned short*)(ws + WS_PEI) + ((size_t)h * NTOK + tok) * 16;
        float* wg = (float*)(ws + WS_PWG) + ((size_t)h * NTOK + tok) * 16;
#pragma unroll
        for (int k4 = 0; k4 < 4; ++k4) {
            if (k4 < 2) *(u32x4*)(ei + k4 * 8) = (u32x4){(unsigned)be[k4 * 8] | ((unsigned)be[k4 * 8 + 1] << 16), (unsigned)be[k4 * 8 + 2] | ((unsigned)be[k4 * 8 + 3] << 16),
                                                         (unsigned)be[k4 * 8 + 4] | ((unsigned)be[k4 * 8 + 5] << 16), (unsigned)be[k4 * 8 + 6] | ((unsigned)be[k4 * 8 + 7] << 16)};
            *(f32x4*)(wg + k4 * 4) = (f32x4){ex[k4 * 4] * inv, ex[k4 * 4 + 1] * inv, ex[k4 * 4 + 2] * inv, ex[k4 * 4 + 3] * inv};
        }
    }
}
__device__ __forceinline__ float dpp_xor1(float v) { return __int_as_float(__builtin_amdgcn_update_dpp(0, __float_as_int(v), 0xB1, 0xf, 0xf, false)); }
__device__ __forceinline__ float dpp_xor2(float v) { return __int_as_float(__builtin_amdgcn_update_dpp(0, __float_as_int(v), 0x4E, 0xf, 0xf, false)); }
__device__ __forceinline__ float dpp_hmirror(float v) { return __int_as_float(__builtin_amdgcn_update_dpp(0, __float_as_int(v), 0x141, 0xf, 0xf, false)); }
constexpr int PEER_UNIT = 512;
typedef int i32x8 __attribute__((ext_vector_type(8)));
typedef int i32x4 __attribute__((ext_vector_type(4)));
__device__ __forceinline__ void peer_u_unit_m(const Args& a, int s, int chunk, LAS unsigned char* lds) {
    unsigned char* ws = a.ws;
    int tid_ = threadIdx.x; asm volatile("" : "+v"(tid_));
    const int lane = tid_ & 63, wave = __builtin_amdgcn_readfirstlane(tid_ >> 6), sub = lane >> 3, c8 = lane & 7, r = lane & 15, q = lane >> 4;
    const unsigned char* EU = ws + WS_EU + (size_t)s * 16384 * 128 + c8 * 16;
    const int tbase = chunk * PEER_UNIT + wave * (PEER_UNIT / 8);
    const unsigned short* ep0 = (const unsigned short*)(ws + WS_PEI) + (size_t)sub * NTOK * 16;
    const unsigned char* hb = ws + WS_H4 + (size_t)(r & 3) * NTOK * (DM / 2) + s * 128 + q * 16;
    bf16_t* slab = (bf16_t*)(ws + WS_SLAB) + (size_t)s * NTOK * 128 + r * 8;
    LAS unsigned char* wl = lds + wave * 16384;
    LAS unsigned char* wrb = wl + (sub * 2) * 128 + ((c8 ^ (((sub & 1) << 1) | (((sub >> 2) & 1) << 2))) * 16);
    const int swr = (((r >> 1) & 1) << 1) | (((r >> 3) & 1) << 2);
    const LAS unsigned char* rd0 = wl + r * 128 + ((q ^ swr) * 16);
    const LAS unsigned char* rd1 = wl + r * 128 + (((4 + q) ^ swr) * 16);
    const int sc_b = 0x80 - 3 * (r & 3);
    u32x4 ev[2], raw[16];
    i32x4 bq0 = {0, 0, 0, 0}, bq1 = {0, 0, 0, 0};
#pragma unroll
    for (int j = 0; j < 2; ++j) ev[j] = *(const u32x4*)(ep0 + (size_t)tbase * 16 + j * 8);
    if (r < NTERM) { bq0 = *(const i32x4*)(hb + (size_t)tbase * (DM / 2)); bq1 = *(const i32x4*)(hb + (size_t)tbase * (DM / 2) + 64); }
#pragma unroll
    for (int g = 0; g < 16; ++g) raw[g] = *(const u32x4*)(EU + (size_t)((ev[g >> 3][(g >> 1) & 3] >> ((g & 1) * 16)) & 0xffffu) * 128);
#pragma unroll
    for (int j = 0; j < 2; ++j) ev[j] = *(const u32x4*)(ep0 + (size_t)(tbase + 1) * 16 + j * 8);
    const i32x4 z4 = {0, 0, 0, 0};
#pragma unroll 1
    for (int i = 0; i < PEER_UNIT / 8; ++i) {
        const int tok = tbase + i;
        const int tn1 = tok + (i + 1 < PEER_UNIT / 8 ? 1 : 0), tn2 = tok + (i + 2 < PEER_UNIT / 8 ? 2 : 0);
#pragma unroll
        for (int g = 0; g < 16; ++g) *(LAS u32x4*)(wrb + (g & 7) * 2048 + (g >> 3) * 128) = raw[g];
        const i32x8 bf0 = __builtin_shufflevector(bq0, z4, 0, 1, 2, 3, 4, 5, 6, 7), bf1 = __builtin_shufflevector(bq1, z4, 0, 1, 2, 3, 4, 5, 6, 7);
        u32x4 ev2[2];
#pragma unroll
        for (int j = 0; j < 2; ++j) ev2[j] = *(const u32x4*)(ep0 + (size_t)tn2 * 16 + j * 8);
        i32x4 bn0 = {0, 0, 0, 0}, bn1 = {0, 0, 0, 0};
        if (r < NTERM) { bn0 = *(const i32x4*)(hb + (size_t)tn1 * (DM / 2)); bn1 = *(const i32x4*)(hb + (size_t)tn1 * (DM / 2) + 64); }
#pragma unroll
        for (int g = 0; g < 16; ++g) raw[g] = *(const u32x4*)(EU + (size_t)((ev[g >> 3][(g >> 1) & 3] >> ((g & 1) * 16)) & 0xffffu) * 128);
        i32x4 af[8][2];
#pragma unroll
        for (int mt = 0; mt < 8; ++mt) { af[mt][0] = *(const LAS i32x4*)(rd0 + mt * 2048); af[mt][1] = *(const LAS i32x4*)(rd1 + mt * 2048); }
        float D[8];
#pragma unroll
        for (int mt = 0; mt < 8; ++mt) {
            const i32x8 af0 = __builtin_shufflevector(af[mt][0], z4, 0, 1, 2, 3, 4, 5, 6, 7), af1 = __builtin_shufflevector(af[mt][1], z4, 0, 1, 2, 3, 4, 5, 6, 7);
            f32x4 acc = __builtin_amdgcn_mfma_scale_f32_16x16x128_f8f6f4(bf0, af0, (f32x4){0.f, 0.f, 0.f, 0.f}, 4, 4, 0, sc_b, 0, 0x79);
            acc = __builtin_amdgcn_mfma_scale_f32_16x16x128_f8f6f4(bf1, af1, acc, 4, 4, 0, sc_b, 0, 0x79);
            asm volatile("" : "+v"(acc));
            D[mt] = (acc[0] + acc[1]) + (acc[2] + acc[3]);
        }
        if (q == 0) { u32x4 w; w.x = cvt_pk_bf16(D[0], D[1]); w.y = cvt_pk_bf16(D[2], D[3]); w.z = cvt_pk_bf16(D[4], D[5]); w.w = cvt_pk_bf16(D[6], D[7]); *(u32x4*)(slab + (size_t)tok * 128) = w; }
#pragma unroll
        for (int j = 0; j < 2; ++j) ev[j] = ev2[j];
        bq0 = bn0; bq1 = bn1;
    }
}

typedef int i32x2 __attribute__((ext_vector_type(2)));
__device__ __forceinline__ void peer_v_unit_m(const Args& a, int s, int chunk, LAS unsigned char* lds) {
    unsigned char* ws = a.ws;
    int tid_ = threadIdx.x; asm volatile("" : "+v"(tid_));
    const int lane = tid_ & 63, wave = __builtin_amdgcn_readfirstlane(tid_ >> 6), sub = lane >> 3, c8 = lane & 7, r = lane & 15, q = lane >> 4;
    const unsigned char* EV = ws + WS_EV + (size_t)s * 16384 * 128 + c8 * 16;
    const int tbase = chunk * PEER_UNIT + wave * (PEER_UNIT / 8);
    const unsigned short* ep0 = (const unsigned short*)(ws + WS_PEI) + (size_t)sub * NTOK * 16;
    const unsigned char* cb = ws + WS_C4 + (size_t)(r & 3) * NTOK * 64 + q * 16;
    LAS unsigned char* wl = lds + wave * 16384;
    LAS unsigned char* wbase = wl + sub * 2048;
    const int c16 = c8 * 16;
    const LAS unsigned char* rdx[8];
#pragma unroll
    for (int c = 0; c < 8; ++c) rdx[c] = wl + (32 * q + r) * 128 + ((c ^ ((r >> 1) & 7)) * 16);
    const int sc_a = 0x7e - 3 * (r & 3);
    float* ob = a.out + s * 256 + r * 16 + q * 4;
    const bf16_t* xb = (const bf16_t*)(ws + WS_X1B) + s * 256 + r * 16 + q * 4;
    u32x4 ev[2], raw[16];
#pragma unroll
    for (int j = 0; j < 2; ++j) ev[j] = *(const u32x4*)(ep0 + (size_t)tbase * 16 + j * 8);
    i32x4 b0 = {0, 0, 0, 0};
    if ((r & 3) < NTERM) b0 = *(const i32x4*)(cb + (size_t)tbase * 64);
    u32x2 xo = *(const u32x2*)(xb + (size_t)tbase * DM);
#pragma unroll
    for (int g = 0; g < 16; ++g) raw[g] = *(const u32x4*)(EV + (size_t)((ev[g >> 3][(g >> 1) & 3] >> ((g & 1) * 16)) & 0xffffu) * 128);
#pragma unroll
    for (int j = 0; j < 2; ++j) ev[j] = *(const u32x4*)(ep0 + (size_t)(tbase + 1) * 16 + j * 8);
    const i32x4 z4 = {0, 0, 0, 0};
#pragma unroll 1
    for (int i = 0; i < PEER_UNIT / 8; ++i) {
        const int tok = tbase + i;
        const int tn1 = tok + (i + 1 < PEER_UNIT / 8 ? 1 : 0), tn2 = tok + (i + 2 < PEER_UNIT / 8 ? 2 : 0);
#pragma unroll
        for (int g = 0; g < 16; ++g) *(LAS u32x4*)(wbase + g * 128 + (c16 ^ (((g >> 1) & 7) * 16))) = raw[g];
        const i32x8 wfrag = __builtin_shufflevector(b0, z4, 0, 1, 2, 3, 4, 5, 6, 7);
        u32x4 ev2[2];
#pragma unroll
        for (int j = 0; j < 2; ++j) ev2[j] = *(const u32x4*)(ep0 + (size_t)tn2 * 16 + j * 8);
        i32x4 bn = {0, 0, 0, 0};
        if ((r & 3) < NTERM) bn = *(const i32x4*)(cb + (size_t)tn1 * 64);
        const u32x2 xn = *(const u32x2*)(xb + (size_t)tn1 * DM);
#pragma unroll
        for (int g = 0; g < 16; ++g) raw[g] = *(const u32x4*)(EV + (size_t)((ev[g >> 3][(g >> 1) & 3] >> ((g & 1) * 16)) & 0xffffu) * 128);
        f32x4 res;
#pragma unroll
        for (int k = 0; k < 4; ++k) {
            float d4[4];
#pragma unroll
            for (int c4 = 0; c4 < 4; ++c4) {
                const int ct = 4 * k + c4;
                const i32x2 t0 = __builtin_amdgcn_ds_read_tr4_b64_v2i32((LAS i32x2*)(rdx[ct >> 1] + (ct & 1) * 8));
                const i32x2 t1 = __builtin_amdgcn_ds_read_tr4_b64_v2i32((LAS i32x2*)(rdx[ct >> 1] + (ct & 1) * 8 + 2048));
                const i32x8 vfrag = {t0[0], t0[1], t1[0], t1[1], 0, 0, 0, 0};
                f32x4 acc = __builtin_amdgcn_mfma_scale_f32_16x16x128_f8f6f4(wfrag, vfrag, (f32x4){0.f, 0.f, 0.f, 0.f}, 4, 4, 0, sc_a, 0, 0x7f);
                asm volatile("" : "+v"(acc));
                d4[c4] = (acc[0] + acc[1]) + (acc[2] + acc[3]);
            }
            res[k] = q == 0 ? d4[0] : q == 1 ? d4[1] : q == 2 ? d4[2] : d4[3];
        }
        *(f32x4*)(ob + (size_t)tok * DM) = (f32x4){bf_lo(xo.x), bf_hi(xo.x), bf_lo(xo.y), bf_hi(xo.y)} + res;
#pragma unroll
        for (int j = 0; j < 2; ++j) ev[j] = ev2[j];
        b0 = bn; xo = xn;
    }
}


__global__ void __launch_bounds__(512, 2) fwd(Args a) {
    extern __shared__ __attribute__((aligned(16))) unsigned char lds_raw[];
    LAS unsigned char* lds = (LAS unsigned char*)lds_raw;
    unsigned char* ws = a.ws;
    const int lo = a.ph_lo, hi = a.ph_hi;
    volatile LAS unsigned* misc = (volatile LAS unsigned*)(lds + MISC_OFF);
    if (threadIdx.x < 4) misc[threadIdx.x] = 0u;
    __syncthreads();
    XcdBarrier bar; bar.bar = (unsigned*)(ws + WS_CTL); bar.x = 0; bar.st = misc;
    if (a.use_bar) bar = xcd_barrier_post((unsigned*)(ws + WS_CTL), misc);
#define IN(k) (lo <= (k) && (k) < hi)
#define SEAM(k) do { if (a.use_bar && IN(k) && IN((k) + 1)) xcd_barrier(bar); } while (0)

    if (IN(0)) { p0_prep(a, lds); }
    SEAM(0);
    if (IN(1)) {
        pg8::Gemm g{(const bf16_t*)(ws + WS_A), (const bf16_t*)(ws + WS_WIN), NTOK, INP, DM};
        pg8::StaticOrder S; S.init(NTOK, INP, gridDim.x, blockIdx.x);
        EpiIn E{ws};
        pg8::gemm_phase<EpiIn, pg8::StaticOrder>(lds, g, S, E);
    }
    SEAM(1);
    unsigned* qctr = (unsigned*)(ws + WS_CTL + 16384);
    volatile LAS int* tslot = (volatile LAS int*)(lds + MISC_OFF + 64);
    if (IN(2)) {
        for (;;) {
            const int it = next_ticket(qctr, tslot);
            if (it >= 1408) break;
            if (it < 128) compress_item(a, it, lds);
            else if (it < 1152) { const int t2 = it - 128, bh = t2 & 63; sb_qblock4(a, bh >> 3, bh & 7, 15 - (t2 >> 6), lds); }
            else fixup_item(a, it - 1152);
        }
    }
    SEAM(2);
    if (IN(3)) {
        for (;;) {
            const int it = next_ticket(qctr + 64, tslot);
            if (it >= 1024) break;
            nsa_item2(a, ((it & 15) << 6) | (63 - (it >> 4)), lds);
        }
    }
    SEAM(3);
    if (IN(4)) { norm_mixed(a); }
    SEAM(4);
    if (IN(5)) {
        pg8::Gemm g{(const bf16_t*)(ws + WS_ORAW), (const bf16_t*)(ws + WS_WOUT), NTOK, DM, DM};
        pg8::StaticOrder S; S.init(NTOK, DM, gridDim.x, blockIdx.x);
        EpiResBf16 E{a.in[0], (bf16_t*)(ws + WS_X1B), (const float*)(ws + WS_RS)};
        pg8::gemm_phase<EpiResBf16, pg8::StaticOrder>(lds, g, S, E);
    }
    SEAM(5);
    if (IN(6)) { rms_terms((const bf16_t*)(ws + WS_X1B), a.in[14], ws + WS_H4, (float*)(ws + WS_RS)); }
    SEAM(6);
    if (IN(7)) {
        pg8::Gemm g{(const bf16_t*)(ws + WS_X1B), (const bf16_t*)(ws + WS_WQ), NTOK, DM, DM};
        pg8::StaticOrder S; S.init(NTOK, DM, gridDim.x, blockIdx.x);
        EpiBf16RowScale E{(bf16_t*)(ws + WS_QP), DM, (const float*)(ws + WS_RS)};
        pg8::gemm_phase<EpiBf16RowScale, pg8::StaticOrder>(lds, g, S, E);
    }
    const bool own8 = IN(7) && IN(8);
    if (!own8) SEAM(7);
    if (IN(8)) {
        const int lane = threadIdx.x & 63, wave = __builtin_amdgcn_readfirstlane(threadIdx.x >> 6);
        pg8::StaticOrder S8; S8.init(NTOK, DM, gridDim.x, blockIdx.x);
        for (int it = 0;; ++it) {
            int tile, tg, h;
            if (own8) { pg8::Unit u; if (!S8.next(it >> 1, u)) break; const int task = wave + 8 * (it & 1); tile = u.pm * 4 + (task >> 2); tg = task & 3; h = u.pn; }
            else { const int tl = blockIdx.x + (it >> 2) * (int)gridDim.x; if (tl >= NTOK / 64) break; const int task = wave + 8 * (it & 3); tile = tl; tg = task & 3; h = task >> 2; }
            peer_topk_task(a, tile, tg, h, lds, lane);
        }
    }
    SEAM(8);
    const int home = (int)(xb_xcc_id() & 7u);
    if (IN(9)) {
        for (int j = 0; j < 8; ++j) {
            const int sl = (home + j) & 7;
            for (int t = next_ticket(qctr + 64 * (2 + sl), tslot); t < NTOK / PEER_UNIT;) { const unsigned nx = ticket_request(qctr + 64 * (2 + sl)); peer_u_unit_m(a, sl, t, lds); t = ticket_publish(nx, tslot); }
        }
    }
    SEAM(9);
    if (IN(10)) {
        const bf16_t* slab = (const bf16_t*)(ws + WS_SLAB); const float* pwg = (const float*)(ws + WS_PWG);
        for (size_t i = ((size_t)blockIdx.x * 512 + threadIdx.x) * 4; i < (size_t)NTOK * 128; i += (size_t)gridDim.x * 512 * 4) {
            f32x4 d = {0.f, 0.f, 0.f, 0.f};
#pragma unroll
            for (int sl = 0; sl < 8; ++sl) { const u32x2 w = *(const u32x2*)(slab + (size_t)sl * NTOK * 128 + i); d[0] += bf_lo(w.x); d[1] += bf_hi(w.x); d[2] += bf_lo(w.y); d[3] += bf_hi(w.y); }
            const f32x4 g4 = *(const f32x4*)(pwg + (((i & 127) >> 4) * (size_t)NTOK + (i >> 7)) * 16 + (i & 15));
            f32x4 o; o[0] = g4[0] * gelu_tanh(d[0]) * 0.35355339f; o[1] = g4[1] * gelu_tanh(d[1]) * 0.35355339f; o[2] = g4[2] * gelu_tanh(d[2]) * 0.35355339f; o[3] = g4[3] * gelu_tanh(d[3]) * 0.35355339f;
            {
                float x0 = o[0] * 2.0f, x1 = o[1] * 2.0f, x2 = o[2] * 2.0f, x3 = o[3] * 2.0f;
#pragma unroll
                for (int t = 0; t < NTERM; ++t) {
                    unsigned p = 0u;
                    p = __builtin_amdgcn_cvt_scalef32_pk_fp4_f32(p, x0, x1, 1.0f, 0); p = __builtin_amdgcn_cvt_scalef32_pk_fp4_f32(p, x2, x3, 1.0f, 1);
                    *(unsigned short*)(ws + WS_C4 + (size_t)t * NTOK * 64 + (i >> 1)) = (unsigned short)p;
                    const f32x2 d01 = __builtin_amdgcn_cvt_scalef32_pk_f32_fp4(p, 1.0f, 0), d23 = __builtin_amdgcn_cvt_scalef32_pk_f32_fp4(p, 1.0f, 1);
                    x0 = (x0 - d01[0]) * 8.0f; x1 = (x1 - d01[1]) * 8.0f; x2 = (x2 - d23[0]) * 8.0f; x3 = (x3 - d23[1]) * 8.0f;
                }
            }
        }
    }
    SEAM(10);
    if (IN(11)) {
        for (int j = 0; j < 8; ++j) {
            const int sl = (home + j) & 7;
            for (int t = next_ticket(qctr + 64 * (18 + sl), tslot); t < NTOK / PEER_UNIT;) { const unsigned nx = ticket_request(qctr + 64 * (18 + sl)); peer_v_unit_m(a, sl, t, lds); t = ticket_publish(nx, tslot); }
        }
    }
#undef IN
#undef SEAM
}


extern "C" void kernel_launch(void* const* d_in, const int* in_sizes, int n_in, void* d_out, int out_size, void* d_ws, size_t ws_size, hipStream_t stream) {
    static int grid = 0;
    if (grid == 0) {
        if (n_in != 19 || out_size != NTOK * DM || ws_size < WS_END) { fprintf(stderr, "kernel_launch: unexpected shapes (n_in %d out %d ws %zu need %zu)\n", n_in, out_size, ws_size, (size_t)WS_END); grid = -1; return; }
        int dev = 0, cus = 0, per_cu = 0;
        if (hipGetDevice(&dev) != hipSuccess || hipDeviceGetAttribute(&cus, hipDeviceAttributeMultiprocessorCount, dev) != hipSuccess) { grid = -1; return; }
        if (hipFuncSetAttribute((const void*)fwd, hipFuncAttributeMaxDynamicSharedMemorySize, LDS_BYTES) != hipSuccess) { fprintf(stderr, "kernel_launch: hipFuncSetAttribute failed\n"); grid = -1; return; }
        if (hipOccupancyMaxActiveBlocksPerMultiprocessor(&per_cu, (const void*)fwd, 512, LDS_BYTES) != hipSuccess || per_cu < 1) { fprintf(stderr, "kernel_launch: occupancy query says %d\n", per_cu); (void)hipGetLastError(); grid = -1; return; }
        grid = cus;
    }
    if (grid < 0) return;
    (void)in_sizes;
    Args a{};
    for (int i = 0; i < 19; ++i) a.in[i] = (const float*)d_in[i];
    a.out = (float*)d_out; a.ws = (unsigned char*)d_ws; a.pad = 0;
#if N_LAUNCH_MODE == 1
    (void)hipMemsetAsync((char*)d_ws + WS_CTL, 0, CTL_BYTES, stream);
    a.ph_lo = 0; a.ph_hi = NPH; a.use_bar = 1;
    hipLaunchKernelGGL(fwd, dim3(grid), dim3(512), LDS_BYTES, stream, a);
#else
    (void)hipMemsetAsync((char*)d_ws + WS_CTL, 0, CTL_BYTES, stream);
    for (int p = 0; p < NPH; ++p) {
        a.ph_lo = p; a.ph_hi = p + 1; a.use_bar = 0;
        hipLaunchKernelGGL(fwd, dim3(grid), dim3(512), LDS_BYTES, stream, a);
    }
#endif
}
```
